# Optimizing an MI355X kernel written in HIP

```python
import math
import jax
import jax.numpy as jnp
from jax import lax
import numpy as np

D_MODEL = 2048
BATCH = 1
SEQ = 16384
DEPTH = 2

MEM_LEN = 256
EPS = 1e-6
RET_HEADS = 8
RET_DK = 128
RET_DV = 128
RET_CHUNK = 128
ROPE_BASE = 10000.0
CONV_WIDTH = 1024
CONV_K = 3
DIFF_HEADS = 4
DIFF_D = 128
Q_BLOCK = 128
T5_BUCKETS = 32
T5_MAX_DIST = 128
X_HEADS = 4
X_HEAD_DIM = 128
D_FF = 7168
N_EXPERTS = 8
TOP_K = 2
N_BRANCH = 3
BRANCH_W = 1024
N_DENSE = (DEPTH + 1) // 2
N_MOE = DEPTH // 2
IN_WIDTHS = (RET_HEADS * RET_DK, RET_HEADS * RET_DK, RET_HEADS * RET_DV, RET_HEADS * RET_DV,
             CONV_WIDTH, CONV_WIDTH, CONV_WIDTH,
             DIFF_HEADS * 2 * DIFF_D, DIFF_HEADS * 2 * DIFF_D, DIFF_HEADS * 2 * DIFF_D,
             N_BRANCH * D_MODEL)
IN_TOTAL = sum(IN_WIDTHS)

kernel_name = 'hybrid_gated_retention_conv_diffattn_moe'


def rmsnorm(x, g=None):
    xf = x.astype(jnp.float32)
    y = xf * lax.rsqrt(jnp.mean(xf * xf, axis=-1, keepdims=True) + EPS)
    if g is not None:
        y = y * g.astype(jnp.float32)
    return y.astype(x.dtype)


def rope(x, pos):
    half = x.shape[-1] // 2
    inv = ROPE_BASE ** (-jnp.arange(half, dtype=jnp.float32) / half)
    ang = pos[:, None].astype(jnp.float32) * inv[None, :]
    cos = jnp.cos(ang)[None, :, None, :]
    sin = jnp.sin(ang)[None, :, None, :]
    x1, x2 = x[..., :half], x[..., half:]
    return jnp.concatenate([x1 * cos - x2 * sin, x1 * sin + x2 * cos], axis=-1).astype(x.dtype)


def retention(q, k, v):
    B, S, H, dk = q.shape
    dv = v.shape[-1]
    C = RET_CHUNK
    N = S // C
    dt = q.dtype
    log_g = jnp.log1p(-(2.0 ** (-5.0 - jnp.arange(H, dtype=jnp.float32))))
    q = q * (dk ** -0.5)
    qc = q.reshape(B, N, C, H, dk)
    kc = k.reshape(B, N, C, H, dk)
    vc = v.reshape(B, N, C, H, dv)
    idx = jnp.arange(C, dtype=jnp.float32)
    dist = idx[:, None] - idx[None, :]
    decay_intra = jnp.where(dist[None] >= 0,
                            jnp.exp(jnp.maximum(dist, 0.0)[None] * log_g[:, None, None]), 0.0).astype(dt)
    scores = jnp.einsum('bnqhd,bnkhd->bnhqk', qc, kc) * decay_intra
    intra = jnp.einsum('bnhqk,bnkhe->bnqhe', scores, vc)
    k_decay = jnp.exp((C - 1 - idx)[:, None] * log_g[None, :]).astype(dt)
    kv = jnp.einsum('bnkhd,bnkhe->bnhde', kc * k_decay[None, None, :, :, None], vc)
    chunk_decay = jnp.exp(C * log_g).astype(kv.dtype)[None, :, None, None]

    def step(state, kv_n):
        return state * chunk_decay + kv_n, state

    _, prev = lax.scan(step, jnp.zeros((B, H, dk, dv), kv.dtype), jnp.moveaxis(kv, 1, 0))
    prev = jnp.moveaxis(prev, 0, 1)
    q_decay = jnp.exp((idx + 1.0)[:, None] * log_g[None, :]).astype(dt)
    cross = jnp.einsum('bnqhd,bnhde->bnqhe', qc * q_decay[None, None, :, :, None], prev)
    return (intra + cross).reshape(B, S, H, dv)


def short_conv(u, b, c, w):
    v = c * u
    y = lax.conv_general_dilated(v, w[:, None, :], window_strides=(1,), padding=[(CONV_K - 1, 0)],
                                 dimension_numbers=('NWC', 'WIO', 'NWC'),
                                 feature_group_count=v.shape[-1])
    return b * y


def t5_bucket(dist):
    max_exact = T5_BUCKETS // 2
    d = jnp.maximum(dist, 0)
    df = jnp.maximum(d, 1).astype(jnp.float32)
    large = max_exact + (jnp.log(df / max_exact) / math.log(T5_MAX_DIST / max_exact)
                         * (T5_BUCKETS - max_exact)).astype(jnp.int32)
    large = jnp.minimum(large, T5_BUCKETS - 1)
    return jnp.where(d < max_exact, d, large)


def diff_attention(q, k, v, lam, lam_init, subln_g, t5_bias):
    B, S, H = q.shape[0], q.shape[1], q.shape[2]
    NQ = S // Q_BLOCK
    scale = DIFF_D ** -0.5
    qb = jnp.moveaxis(q.reshape(B, NQ, Q_BLOCK, H, 2, DIFF_D), 1, 0)
    kpos = jnp.arange(S, dtype=jnp.int32)
    bias_tab = t5_bias.T.astype(jnp.float32)

    def block(args):
        q_blk, i = args
        qpos = i * Q_BLOCK + jnp.arange(Q_BLOCK, dtype=jnp.int32)
        dist = qpos[:, None] - kpos[None, :]
        bias = bias_tab[:, t5_bucket(dist)]
        logits = jnp.einsum('bqhmd,bkhmd->bmhqk', q_blk, k).astype(jnp.float32) * scale + bias[None, None]
        logits = jnp.where(dist >= 0, logits, -1e30)
        p = jax.nn.softmax(logits, axis=-1)
        a = p[:, 0] - lam * p[:, 1]
        return jnp.einsum('bhqk,bkhe->bqhe', a.astype(v.dtype), v)

    o = lax.map(block, (qb, jnp.arange(NQ, dtype=jnp.int32)))
    o = jnp.moveaxis(o, 0, 1).reshape(B, S, H, 2 * DIFF_D)
    o = rmsnorm(o, subln_g) * (1.0 - lam_init)
    return o.reshape(B, S, H * 2 * DIFF_D)


def cross_attention(h, mem_n, wq, wkv, wo):
    B, S, _ = h.shape
    M = mem_n.shape[1]
    q = (h @ wq).reshape(B, S, X_HEADS, X_HEAD_DIM)
    kv = (mem_n @ wkv).reshape(B, M, 2, X_HEADS, X_HEAD_DIM)
    k, v = kv[:, :, 0], kv[:, :, 1]
    logits = jnp.einsum('bshd,bmhd->bhsm', q, k).astype(jnp.float32) * (X_HEAD_DIM ** -0.5)
    p = jax.nn.softmax(logits, axis=-1)
    o = jnp.einsum('bhsm,bmhd->bshd', p.astype(v.dtype), v).reshape(B, S, X_HEADS * X_HEAD_DIM)
    return o @ wo


def swiglu(h, wg, wu, wd):
    return (jax.nn.silu(h @ wg) * (h @ wu)) @ wd


def moe_swiglu(h, w_router, wg, wu, wd):
    B, S, D = h.shape
    hf = h.reshape(B * S, D)
    logits = (hf @ w_router).astype(jnp.float32)
    top_v, top_i = lax.top_k(logits, TOP_K)
    gate = jax.nn.softmax(top_v, axis=-1)
    combine = jnp.sum(jax.nn.one_hot(top_i, N_EXPERTS, dtype=jnp.float32) * gate[..., None], axis=1)
    out = jnp.zeros_like(hf)
    for e in range(N_EXPERTS):
        ye = swiglu(hf, wg[e], wu[e], wd[e])
        out = out + combine[:, e:e + 1].astype(hf.dtype) * ye
    return out.reshape(B, S, D)


def setup_inputs(seed: int = 0) -> dict:
    key = jax.random.key(seed)
    ks = jax.random.split(key, 32)
    f32 = jnp.float32

    def nrm(k, shape, fan_in):
        return jax.random.normal(k, shape, f32) * (fan_in ** -0.5)

    def gain(k, shape):
        return 1.0 + 0.02 * jax.random.normal(k, shape, f32)

    return {
        'x': jax.random.normal(ks[0], (BATCH, SEQ, D_MODEL), f32),
        'mem': jax.random.normal(ks[1], (BATCH, MEM_LEN, D_MODEL), f32),
        't5_bias': 0.5 * jax.random.normal(ks[2], (T5_BUCKETS, DIFF_HEADS), f32),
        'w_in': nrm(ks[3], (DEPTH, D_MODEL, IN_TOTAL), D_MODEL),
        'w_conv': nrm(ks[4], (DEPTH, CONV_K, CONV_WIDTH), CONV_K),
        'diff_lambda': 0.1 * jax.random.normal(ks[5], (DEPTH, 4, DIFF_D), f32),
        'diff_subln': gain(ks[6], (DEPTH, 2 * DIFF_D)),
        'w_branch': nrm(ks[7], (DEPTH, N_BRANCH, BRANCH_W, D_MODEL), BRANCH_W),
        'w_mix_out': nrm(ks[8], (DEPTH, D_MODEL, D_MODEL), D_MODEL),
        'w_xq': nrm(ks[9], (DEPTH, D_MODEL, X_HEADS * X_HEAD_DIM), D_MODEL),
        'w_xkv': nrm(ks[10], (DEPTH, D_MODEL, 2 * X_HEADS * X_HEAD_DIM), D_MODEL),
        'w_xo': nrm(ks[11], (DEPTH, X_HEADS * X_HEAD_DIM, D_MODEL), X_HEADS * X_HEAD_DIM),
        'w_ffn_gate': nrm(ks[12], (N_DENSE, D_MODEL, D_FF), D_MODEL),
        'w_ffn_up': nrm(ks[13], (N_DENSE, D_MODEL, D_FF), D_MODEL),
        'w_ffn_down': nrm(ks[14], (N_DENSE, D_FF, D_MODEL), D_FF),
        'w_router': nrm(ks[15], (N_MOE, D_MODEL, N_EXPERTS), D_MODEL),
        'w_exp_gate': nrm(ks[16], (N_MOE, N_EXPERTS, D_MODEL, D_FF), D_MODEL),
        'w_exp_up': nrm(ks[17], (N_MOE, N_EXPERTS, D_MODEL, D_FF), D_MODEL),
        'w_exp_down': nrm(ks[18], (N_MOE, N_EXPERTS, D_FF, D_MODEL), D_FF),
        'g_pre_mix': gain(ks[19], (DEPTH, D_MODEL)),
        'g_post_mix': gain(ks[20], (DEPTH, D_MODEL)),
        'g_pre_xattn': gain(ks[21], (DEPTH, D_MODEL)),
        'g_mem': gain(ks[22], (DEPTH, D_MODEL)),
        'g_post_xattn': gain(ks[23], (DEPTH, D_MODEL)),
        'g_pre_ffn': gain(ks[24], (DEPTH, D_MODEL)),
        'g_post_ffn': gain(ks[25], (DEPTH, D_MODEL)),
    }


def reference(x, mem, t5_bias, w_in, w_conv, diff_lambda, diff_subln, w_branch, w_mix_out,
              w_xq, w_xkv, w_xo, w_ffn_gate, w_ffn_up, w_ffn_down, w_router, w_exp_gate,
              w_exp_up, w_exp_down, g_pre_mix, g_post_mix, g_pre_xattn, g_mem, g_post_xattn,
              g_pre_ffn, g_post_ffn):
    B, S, D = x.shape
    pos = jnp.arange(S, dtype=jnp.int32)
    split_pts = [int(p) for p in np.cumsum(IN_WIDTHS)[:-1]]
    for l in range(DEPTH):
        h = rmsnorm(x, g_pre_mix[l])
        (rq, rk, rv, rg, cb, cc, cu, dq, dk, dv, gl) = jnp.split(h @ w_in[l], split_pts, axis=-1)
        rq = rope(rq.reshape(B, S, RET_HEADS, RET_DK), pos)
        rk = rope(rk.reshape(B, S, RET_HEADS, RET_DK), pos)
        y_a = retention(rq, rk, rv.reshape(B, S, RET_HEADS, RET_DV))
        y_a = jax.nn.silu(rg) * rmsnorm(y_a).reshape(B, S, RET_HEADS * RET_DV)
        y_b = short_conv(cu, cb, cc, w_conv[l])
        lq1, lk1, lq2, lk2 = diff_lambda[l]
        lam_init = 0.8 - 0.6 * math.exp(-0.3 * l)
        lam = (jnp.exp(jnp.sum(lq1 * lk1).astype(jnp.float32))
               - jnp.exp(jnp.sum(lq2 * lk2).astype(jnp.float32)) + lam_init)
        y_c = diff_attention(dq.reshape(B, S, DIFF_HEADS, 2, DIFF_D), dk.reshape(B, S, DIFF_HEADS, 2, DIFF_D),
                             dv.reshape(B, S, DIFF_HEADS, 2 * DIFF_D), lam, lam_init, diff_subln[l], t5_bias)
        ys = jnp.stack([y_a, y_b, y_c], axis=2)
        z = jnp.einsum('bsnc,ncd->bsnd', ys, w_branch[l])
        gates = jax.nn.sigmoid(gl.reshape(B, S, N_BRANCH, D))
        merged = jnp.sum(gates * z, axis=2)
        x = x + rmsnorm(merged @ w_mix_out[l], g_post_mix[l])
        h = rmsnorm(x, g_pre_xattn[l])
        mem_n = rmsnorm(mem, g_mem[l])
        x = x + rmsnorm(cross_attention(h, mem_n, w_xq[l], w_xkv[l], w_xo[l]), g_post_xattn[l])
        h = rmsnorm(x, g_pre_ffn[l])
        if l % 2 == 0:
            f = swiglu(h, w_ffn_gate[l // 2], w_ffn_up[l // 2], w_ffn_down[l // 2])
        else:
            f = moe_swiglu(h, w_router[l // 2], w_exp_gate[l // 2], w_exp_up[l // 2], w_exp_down[l // 2])
        x = x + rmsnorm(f, g_post_ffn[l])
    return x
```

```cpp
#include <hip/hip_runtime.h>
#include <cstdio>
#include <cstdint>

#ifndef ONE_LAUNCH
#define ONE_LAUNCH 0
#endif

#define LAS __attribute__((address_space(3)))
typedef unsigned short bf16_t;
typedef short bf16x8 __attribute__((ext_vector_type(8)));
typedef short s16x4 __attribute__((ext_vector_type(4)));
typedef float f32x4 __attribute__((ext_vector_type(4)));
typedef float f32x2 __attribute__((ext_vector_type(2)));
typedef float f32x16 __attribute__((ext_vector_type(16)));
typedef unsigned u32x4 __attribute__((ext_vector_type(4)));
typedef unsigned u32x2 __attribute__((ext_vector_type(2)));

constexpr int S = 16384, DM = 2048, DEPTH = 2, MEM_LEN = 256;
constexpr int NIN = 16384;
constexpr int C_RQ = 0, C_RK = 1024, C_RV = 2048, C_RG = 3072, C_CB = 4096, C_CC = 5120, C_CU = 6144, C_DQ = 7168, C_DK = 8192, C_DV = 9216, C_GL = 10240;
constexpr int DFF = 7168, NEXP = 8;
constexpr float EPS = 1e-6f;
constexpr int MOE_MAXROWS = 2 * S + NEXP * 256;

constexpr size_t MiB = 1u << 20;
constexpr size_t WS_CTL = 0, CTL_ZERO_BYTES = 64 * 1024;
constexpr size_t WS_KVX = 1 * MiB;
constexpr size_t WS_MEMN = 2 * MiB;
constexpr size_t WS_ROUTE = 3 * MiB;
constexpr size_t WS_SLOTTOK = 4 * MiB;
constexpr size_t WS_HIST = 5 * MiB;
constexpr size_t WS_ROPE = 6 * MiB;
constexpr size_t WS_W = 16 * MiB;
constexpr size_t WS_WIN = WS_W;
constexpr size_t WS_WBR = WS_WIN + 128 * MiB;
constexpr size_t WS_WMIX = WS_WBR + 24 * MiB;
constexpr size_t WS_WXQ = WS_WMIX + 16 * MiB;
constexpr size_t WS_WXKV = WS_WXQ + 4 * MiB;
constexpr size_t WS_WXO = WS_WXKV + 8 * MiB;
constexpr size_t WS_WGU = WS_WXO + 4 * MiB;
constexpr size_t WS_WDN = WS_WGU + 56 * MiB;
constexpr size_t WS_WEGU = WS_WDN + 28 * MiB;
constexpr size_t WS_WEDN = WS_WEGU + 448 * MiB;
constexpr size_t WS_P = WS_WEDN + 224 * MiB;
constexpr size_t WS_H = WS_P + 512 * MiB;
constexpr size_t WS_Y = WS_H + 64 * MiB;
constexpr size_t WS_Y3 = WS_Y + 64 * MiB;
constexpr size_t WS_OT = WS_Y3 + 96 * MiB;
constexpr size_t WS_MG = WS_OT + 64 * MiB;
constexpr size_t WS_QX = WS_MG, WS_OX = WS_MG + 16 * MiB;
constexpr size_t WS_YS = WS_MG + 64 * MiB;
constexpr size_t WS_KVS = WS_YS, WS_PRV = WS_YS + 64 * MiB;
constexpr size_t WS_END = WS_YS + 136 * MiB;
static_assert(WS_END <= (size_t)2010 * MiB, "workspace map exceeds the guaranteed size");

constexpr int LDS_BYTES = 163840;
constexpr int LDS_CTL_OFF = 163328;

__device__ __forceinline__ float bf2f(unsigned b) { return __uint_as_float(b << 16); }
__device__ __forceinline__ unsigned f2bf(float f) { unsigned u = __float_as_uint(f); return (u + 0x7fffu + ((u >> 16) & 1u)) >> 16; }
__device__ __forceinline__ unsigned pk2(float lo, float hi) { return f2bf(lo) | (f2bf(hi) << 16); }
__device__ __forceinline__ unsigned cvt_pk_bf16(float lo, float hi) { unsigned r; asm volatile("v_cvt_pk_bf16_f32 %0, %1, %2" : "=v"(r) : "v"(lo), "v"(hi)); return r; }
__device__ __forceinline__ float wave_sum(float v) {
#pragma unroll
    for (int o = 1; o < 64; o <<= 1) v += __shfl_xor(v, o);
    return v;
}
__device__ __forceinline__ float fast_sigmoid(float x) { return __builtin_amdgcn_rcpf(1.0f + __builtin_amdgcn_exp2f(-1.4426950408889634f * x)); }
#define LDS_WAIT() asm volatile("s_waitcnt lgkmcnt(0)" ::: "memory")
#define VM_WAIT() asm volatile("s_waitcnt vmcnt(0)" ::: "memory")

namespace pg8 {
constexpr int BM = 256, BK = 64, HALF = 128, HTB = HALF * BK * 2, STAGE_BYTES = 8 * HTB, NXCD = 8, WGM = 8;
__host__ __device__ __forceinline__ int lds_byte(int r, int c) { const int st = (r >> 4) * 2 + (c >> 5), rr = r & 15, cc = c & 31, ob = rr * 64 + cc * 2; return st * 1024 + (ob ^ (((ob >> 9) & 1) << 5)); }
__host__ __device__ __forceinline__ void stage_rc(int b, int& R, int& C) { const int st = b / 1024, sb = b % 1024, swz = sb ^ (((sb >> 9) & 1) << 5); R = (st >> 1) * 16 + swz / 64; C = (st & 1) * 32 + (swz % 64) / 2; }
__host__ __device__ __forceinline__ int perm32(int rho) { const int n = rho >> 4, i = rho & 15; return 8 * (i >> 2) + 4 * n + (i & 3); }

struct Unit { int pm, pn, e; };
struct Gemm { const bf16_t* A; const bf16_t* Bt; int M, N, K; size_t bstride, astride; };

struct StaticOrder {
    static constexpr bool GATHER = false;
    int nM, nN, nwg, G, c;
    __device__ __forceinline__ void init(int M, int N, int G_, int c_) { nM = M / BM; nN = N / BM; nwg = nM * nN; G = G_; c = c_; }
    __device__ __forceinline__ bool next(int i, Unit& u) const {
        const long L = (long)i * G + c; if (L >= nwg) return false;
        int wgid = (int)L; { const int q = nwg / NXCD, r = nwg % NXCD, xcd = wgid % NXCD, off = wgid / NXCD; wgid = (xcd < r ? xcd * (q + 1) : r * (q + 1) + (xcd - r) * q) + off; }
        const int nig = WGM * nN, gid = wgid / nig, fm = gid * WGM, gsz = (nM - fm) < WGM ? (nM - fm) : WGM;
        u.pm = fm + ((wgid % nig) % gsz); u.pn = (wgid % nig) / gsz; u.e = 0; return true;
    }
    __device__ __forceinline__ int tok(int) const { return 0; }
};
template <bool GATH> struct MoeOrder {
    static constexpr bool GATHER = GATH;
    int nM, nN, nwg, G, c; int ts1, ts2, ts3, ts4, ts5, ts6, ts7; const int* tokp;
    __device__ __forceinline__ void init(const int* tstart, int N, int G_, int c_, const int* tokp_) {
        nM = tstart[8]; nN = N / BM; nwg = nM * nN; G = G_; c = c_; tokp = tokp_;
        ts1 = tstart[1]; ts2 = tstart[2]; ts3 = tstart[3]; ts4 = tstart[4]; ts5 = tstart[5]; ts6 = tstart[6]; ts7 = tstart[7];
    }
    __device__ __forceinline__ bool next(int i, Unit& u) const {
        const long L = (long)i * G + c; if (L >= nwg) return false;
        int wgid = (int)L; { const int q = nwg / NXCD, r = nwg % NXCD, xcd = wgid % NXCD, off = wgid / NXCD; wgid = (xcd < r ? xcd * (q + 1) : r * (q + 1) + (xcd - r) * q) + off; }
        const int nig = WGM * nN, gid = wgid / nig, fm = gid * WGM, gsz = (nM - fm) < WGM ? (nM - fm) : WGM;
        u.pm = fm + ((wgid % nig) % gsz); u.pn = (wgid % nig) / gsz;
        u.e = (u.pm >= ts1) + (u.pm >= ts2) + (u.pm >= ts3) + (u.pm >= ts4) + (u.pm >= ts5) + (u.pm >= ts6) + (u.pm >= ts7); return true;
    }
    __device__ __forceinline__ int tok(int row) const { return tokp[row]; }
};

template <int MODE> struct EpiStore {
    static constexpr bool MID = false;
    bf16_t* O; int ldc;
    __device__ __forceinline__ bool operator()(f32x4 (&acc)[2][2][4][2], const Unit& u, int wr, int wc, int fr, int fq) const {
        const int row0 = u.pm * BM + wr * 64 + fr, col0 = u.pn * BM + wc * 32 + 8 * fq;
        const int act = (MODE == 1) ? ((u.pn >= 12 && u.pn < 16) ? 1 : (u.pn >= 40 ? 2 : 0)) : 0;
#pragma unroll
        for (int ai = 0; ai < 2; ++ai)
#pragma unroll
            for (int m = 0; m < 4; ++m) { bf16_t* rowp = O + (size_t)(row0 + ai * HALF + m * 16) * ldc + col0;
#pragma unroll
                for (int bj = 0; bj < 2; ++bj) { f32x4 v0 = acc[ai][bj][m][0], v1 = acc[ai][bj][m][1];
                    if (MODE == 1 && act != 0) {
#pragma unroll
                        for (int j = 0; j < 4; ++j) { const float s0 = fast_sigmoid(v0[j]), s1 = fast_sigmoid(v1[j]);
                            v0[j] = (act == 1) ? v0[j] * s0 : fmaxf(s0, 1e-6f); v1[j] = (act == 1) ? v1[j] * s1 : fmaxf(s1, 1e-6f); } }
                    u32x4 w; w.x = cvt_pk_bf16(v0[0], v0[1]); w.y = cvt_pk_bf16(v0[2], v0[3]); w.z = cvt_pk_bf16(v1[0], v1[1]); w.w = cvt_pk_bf16(v1[2], v1[3]);
                    *(u32x4*)(rowp + bj * HALF) = w; } }
        return false;
    }
};
struct EpiSwiglu {
    static constexpr bool MID = false;
    bf16_t* O; int ldc;
    __device__ __forceinline__ bool operator()(f32x4 (&acc)[2][2][4][2], const Unit& u, int wr, int wc, int fr, int fq) const {
        const int row0 = u.pm * BM + wr * 64 + fr, col0 = u.pn * HALF + wc * 32 + 8 * fq;
#pragma unroll
        for (int ai = 0; ai < 2; ++ai)
#pragma unroll
            for (int m = 0; m < 4; ++m) { bf16_t* rowp = O + (size_t)(row0 + ai * HALF + m * 16) * ldc + col0;
                f32x4 v0, v1;
#pragma unroll
                for (int j = 0; j < 4; ++j) { const float g0 = acc[ai][0][m][0][j], g1 = acc[ai][0][m][1][j];
                    v0[j] = g0 * fast_sigmoid(g0) * acc[ai][1][m][0][j]; v1[j] = g1 * fast_sigmoid(g1) * acc[ai][1][m][1][j]; }
                u32x4 w; w.x = cvt_pk_bf16(v0[0], v0[1]); w.y = cvt_pk_bf16(v0[2], v0[3]); w.z = cvt_pk_bf16(v1[0], v1[1]); w.w = cvt_pk_bf16(v1[2], v1[3]);
                *(u32x4*)rowp = w; }
        return false;
    }
};
struct EpiMerge {
    static constexpr bool MID = false;
    bf16_t* O; int ldc; const bf16_t* G; int ldg;
    __device__ __forceinline__ void gate8(const bf16_t* p, float (&g)[8]) const {
        const u32x4 w = *(const u32x4*)p;
        g[0] = bf2f(w.x & 0xffffu); g[1] = bf2f(w.x >> 16); g[2] = bf2f(w.y & 0xffffu); g[3] = bf2f(w.y >> 16);
        g[4] = bf2f(w.z & 0xffffu); g[5] = bf2f(w.z >> 16); g[6] = bf2f(w.w & 0xffffu); g[7] = bf2f(w.w >> 16);
    }
    __device__ __forceinline__ bool operator()(f32x4 (&acc)[2][2][4][2], const Unit& u, int wr, int wc, int fr, int fq) const {
        const int row0 = u.pm * BM + wr * 64 + fr, col0 = u.pn * BM + wc * 32 + 8 * fq;
        if (u.e < 2) {
#pragma unroll
            for (int ai = 0; ai < 2; ++ai)
#pragma unroll
                for (int m = 0; m < 4; ++m) { const bf16_t* gp = G + (size_t)(row0 + ai * HALF + m * 16) * ldg + col0 + u.e * 2048;
#pragma unroll
                    for (int bj = 0; bj < 2; ++bj) { float a[8], b[8]; gate8(gp + bj * HALF, a); gate8(gp + bj * HALF + 2048, b);
#pragma unroll
                        for (int j = 0; j < 4; ++j) { acc[ai][bj][m][0][j] *= a[j] * __builtin_amdgcn_rcpf(b[j]); acc[ai][bj][m][1][j] *= a[4 + j] * __builtin_amdgcn_rcpf(b[4 + j]); } }
                    if (m & 1) asm volatile("" : "+v"(acc[ai][0][m][0]), "+v"(acc[ai][0][m][1]), "+v"(acc[ai][1][m][0]), "+v"(acc[ai][1][m][1]) :: "memory"); }
            return true;
        }
#pragma unroll
        for (int ai = 0; ai < 2; ++ai)
#pragma unroll
            for (int m = 0; m < 4; ++m) { const size_t r = (size_t)(row0 + ai * HALF + m * 16); const bf16_t* gp = G + r * ldg + col0 + 2 * 2048; bf16_t* rowp = O + r * ldc + col0;
#pragma unroll
                for (int bj = 0; bj < 2; ++bj) { float c[8]; gate8(gp + bj * HALF, c); const f32x4 v0 = acc[ai][bj][m][0], v1 = acc[ai][bj][m][1];
                    u32x4 w; w.x = cvt_pk_bf16(v0[0] * c[0], v0[1] * c[1]); w.y = cvt_pk_bf16(v0[2] * c[2], v0[3] * c[3]); w.z = cvt_pk_bf16(v1[0] * c[4], v1[1] * c[5]); w.w = cvt_pk_bf16(v1[2] * c[6], v1[3] * c[7]);
                    *(u32x4*)(rowp + bj * HALF) = w; }
                if (m & 1) asm volatile("" ::: "memory"); }
        return false;
    }
};
struct MergeOrder {
    static constexpr bool GATHER = false;
    StaticOrder so;
    __device__ __forceinline__ void init(int M, int N, int G_, int c_) { so.init(M, N, G_, c_); }
    __device__ __forceinline__ bool next(int i, Unit& u) const { const int q = i / 3; if (!so.next(q, u)) return false; u.e = i - 3 * q; return true; }
    __device__ __forceinline__ int tok(int) const { return 0; }
};

template <class Epi, class Sched>
__device__ __forceinline__ void gemm_phase(LAS unsigned char* lds, const Gemm g, const Sched& S, const Epi& E) {
    int tid = threadIdx.x; asm volatile("" : "+v"(tid));
    const int wid = __builtin_amdgcn_readfirstlane(tid >> 6), lane = tid & 63, wr = wid >> 2, wc = wid & 3, fr = lane & 15, fq = lane >> 4;
    const int K = g.K, nt = K / BK;
    unsigned voffA[2], voffB[2];
#pragma unroll
    for (int i = 0; i < 2; ++i) { int R, C; stage_rc(tid * 16 + i * 8192, R, C); const int Rb = (R & ~31) + perm32(R & 31);
        voffA[i] = (unsigned)(R * K + C) * 2u; voffB[i] = (unsigned)(Rb * K + C) * 2u; }
    const size_t kstep = (size_t)(BK * 2);
    const size_t hstep = (size_t)HALF * K * 2;
    const size_t tstep = 2 * hstep;
    const unsigned ldsw = (unsigned)wid * 1024u;
    const int aoff = lds_byte(wr * 64 + fr, fq * 8), boff = lds_byte(wc * 32 + fr, fq * 8);
#define PG8_SA(b, h) (((b) * 2 + (h)) * HTB)
#define PG8_SB(b, h) ((4 + (b) * 2 + (h)) * HTB)
#define PG8_STAGE(bufoff, gbase, voff) do { _Pragma("unroll") for (int _i = 0; _i < 2; ++_i) \
        __builtin_amdgcn_global_load_lds((const unsigned*)((const char*)(gbase) + (voff)[_i]), (LAS unsigned*)(lds + (bufoff) + ldsw + _i * 8192), 16, 0, 0); } while (0)
#define PG8_STAGE_A(bufoff, nx, h, kt) do { if constexpr (Sched::GATHER) { unsigned _o[2]; _o[0] = (nx) ? ngofs[h][0] : gofs[h][0]; _o[1] = (nx) ? ngofs[h][1] : gofs[h][1]; \
            PG8_STAGE(bufoff, (const char*)g.A + (size_t)(kt) * kstep, _o); } \
        else { PG8_STAGE(bufoff, ((nx) ? nA : cA) + (size_t)(h) * hstep + (size_t)(kt) * kstep, voffA); } } while (0)
#define PG8_LDA(dst, b, h) do { _Pragma("unroll") for (int m = 0; m < 4; ++m) _Pragma("unroll") for (int k = 0; k < 2; ++k) dst[m][k] = *(const LAS bf16x8*)(lds + PG8_SA(b, h) + aoff + m * 2048 + k * 1024); } while (0)
#define PG8_LDB(dst, b, h) do { _Pragma("unroll") for (int n = 0; n < 2; ++n) _Pragma("unroll") for (int k = 0; k < 2; ++k) dst[n][k] = *(const LAS bf16x8*)(lds + PG8_SB(b, h) + boff + n * 2048 + k * 1024); } while (0)
#define PG8_MMA(ai, bj, At, Bt) do { __builtin_amdgcn_s_setprio(1); _Pragma("unroll") for (int m = 0; m < 4; ++m) _Pragma("unroll") for (int n = 0; n < 2; ++n) _Pragma("unroll") for (int k = 0; k < 2; ++k) \
        acc[ai][bj][m][n] = __builtin_amdgcn_mfma_f32_16x16x32_bf16(Bt[n][k], At[m][k], acc[ai][bj][m][n], 0, 0, 0); __builtin_amdgcn_s_setprio(0); } while (0)
#define PG8_WAIT_V(n) asm volatile("s_waitcnt vmcnt(" #n ")" ::: "memory")
#define PG8_WAIT_L(n) asm volatile("s_waitcnt lgkmcnt(" #n ")" ::: "memory")
#define PG8_BAR __builtin_amdgcn_s_barrier()
#define PG8_SCHED __builtin_amdgcn_sched_barrier(0)
#define PG8_GOFS(dst, u_) do { _Pragma("unroll") for (int _h = 0; _h < 2; ++_h) _Pragma("unroll") for (int _i = 0; _i < 2; ++_i) \
        { int _R, _C; stage_rc(tid * 16 + _i * 8192, _R, _C); dst[_h][_i] = (unsigned)(S.tok((u_).pm * BM + _h * HALF + _R) * K + _C) * 2u; } } while (0)
    Unit cur, nxt; int ui = 0;
    if (!S.next(0, cur)) return;
    f32x4 acc[2][2][4][2];
#pragma unroll
    for (int a = 0; a < 2; ++a)
#pragma unroll
        for (int b = 0; b < 2; ++b)
#pragma unroll
            for (int m = 0; m < 4; ++m)
#pragma unroll
                for (int n = 0; n < 2; ++n) acc[a][b][m][n] = (f32x4){0.f, 0.f, 0.f, 0.f};
    bf16x8 At[4][2], B0[2][2], B1[2][2];
    unsigned gofs[2][2] = {{0u, 0u}, {0u, 0u}}, ngofs[2][2] = {{0u, 0u}, {0u, 0u}};
    if constexpr (Sched::GATHER) { PG8_GOFS(gofs, cur); }
    const char* cA = (const char*)g.A + (Sched::GATHER ? (size_t)0 : (size_t)cur.pm * tstep + (size_t)cur.e * g.astride); const char* nA = cA;
    const char* cB = (const char*)g.Bt + (size_t)cur.e * g.bstride + (size_t)cur.pn * tstep;
    PG8_STAGE(PG8_SB(0, 0), cB, voffB); PG8_STAGE_A(PG8_SA(0, 0), false, 0, 0); PG8_STAGE(PG8_SB(0, 1), cB + hstep, voffB); PG8_STAGE_A(PG8_SA(0, 1), false, 1, 0);
    if (wr == 1) PG8_BAR;
    PG8_WAIT_V(4); PG8_BAR;
    PG8_STAGE(PG8_SB(1, 0), cB + kstep, voffB); PG8_STAGE_A(PG8_SA(1, 0), false, 0, 1); PG8_STAGE(PG8_SB(1, 1), cB + hstep + kstep, voffB);
    PG8_WAIT_V(6); PG8_BAR;
    for (;;) {
        const bool has_next = S.next(ui + 1, nxt);
        if constexpr (Sched::GATHER) { if (has_next) { PG8_GOFS(ngofs, nxt); } else { _Pragma("unroll") for (int _h = 0; _h < 2; ++_h) _Pragma("unroll") for (int _i = 0; _i < 2; ++_i) ngofs[_h][_i] = gofs[_h][_i]; } }
        else { nA = has_next ? (const char*)g.A + (size_t)nxt.pm * tstep + (size_t)nxt.e * g.astride : cA; }
        const char* nB = has_next ? (const char*)g.Bt + (size_t)nxt.e * g.bstride + (size_t)nxt.pn * tstep : cB;
        for (int t = 0; t < nt; t += 2) {
            const bool last = (t == nt - 2);
            const char* b2 = last ? nB : cB + (size_t)(t + 2) * kstep; const char* b3 = b2 + kstep;
            const int kt2 = last ? 0 : t + 2, kt3 = kt2 + 1;
            PG8_LDB(B0, 0, 0); PG8_SCHED; PG8_LDA(At, 0, 0); PG8_STAGE_A(PG8_SA(1, 1), false, 1, t + 1);
            PG8_WAIT_L(8); PG8_BAR; PG8_WAIT_L(0); PG8_MMA(0, 0, At, B0); PG8_BAR; PG8_SCHED;
            PG8_LDB(B1, 0, 1); PG8_STAGE(PG8_SB(0, 0), b2, voffB);
            PG8_BAR; PG8_WAIT_L(0); PG8_MMA(0, 1, At, B1); PG8_BAR;
            PG8_LDA(At, 0, 1); PG8_STAGE_A(PG8_SA(0, 0), last, 0, kt2);
            PG8_BAR; PG8_WAIT_L(0); PG8_MMA(1, 0, At, B0); PG8_BAR; PG8_SCHED;
            PG8_STAGE(PG8_SB(0, 1), b2 + hstep, voffB);
            PG8_WAIT_V(6); PG8_BAR; PG8_MMA(1, 1, At, B1); PG8_BAR;
            PG8_LDB(B0, 1, 0); PG8_SCHED; PG8_LDA(At, 1, 0); PG8_STAGE_A(PG8_SA(0, 1), last, 1, kt2);
            PG8_WAIT_L(8); PG8_BAR; PG8_WAIT_L(0); PG8_MMA(0, 0, At, B0); PG8_BAR; PG8_SCHED;
            PG8_LDB(B1, 1, 1); PG8_STAGE(PG8_SB(1, 0), b3, voffB);
            PG8_BAR; PG8_WAIT_L(0); PG8_MMA(0, 1, At, B1); PG8_BAR;
            PG8_LDA(At, 1, 1); PG8_STAGE_A(PG8_SA(1, 0), last, 0, kt3);
            PG8_BAR; PG8_WAIT_L(0); PG8_MMA(1, 0, At, B0); PG8_BAR; PG8_SCHED;
            PG8_STAGE(PG8_SB(1, 1), b3 + hstep, voffB);
            PG8_WAIT_V(6); PG8_BAR; PG8_MMA(1, 1, At, B1); PG8_BAR;
        }
        const bool keep = E(acc, cur, wr, wc, fr, fq);
        if (!has_next) break;
        if (!keep) {
#pragma unroll
        for (int a = 0; a < 2; ++a)
#pragma unroll
            for (int b = 0; b < 2; ++b)
#pragma unroll
                for (int m = 0; m < 4; ++m)
#pragma unroll
                    for (int n = 0; n < 2; ++n) acc[a][b][m][n] = (f32x4){0.f, 0.f, 0.f, 0.f};
        }
        cur = nxt; cA = nA; cB = nB; ++ui;
        if constexpr (Sched::GATHER) { _Pragma("unroll") for (int _h = 0; _h < 2; ++_h) _Pragma("unroll") for (int _i = 0; _i < 2; ++_i) gofs[_h][_i] = ngofs[_h][_i]; }
    }
    PG8_WAIT_V(0);
    if (wr == 0) PG8_BAR;
    PG8_BAR;
#undef PG8_SA
#undef PG8_SB
#undef PG8_STAGE
#undef PG8_STAGE_A
#undef PG8_LDA
#undef PG8_LDB
#undef PG8_MMA
#undef PG8_WAIT_V
#undef PG8_WAIT_L
#undef PG8_BAR
#undef PG8_SCHED
#undef PG8_GOFS
}
}

namespace att {
constexpr int D = 128, NW = 8, QBLK = 32, KVBLK = 64, QB = NW * QBLK;
constexpr int SHM_V = KVBLK * D * 2, SHM_K = KVBLK * D * 2;
constexpr int ATT_WS_OFF = 2 * SHM_V + 2 * SHM_K;
constexpr int ATT_BIAS_OFF = ATT_WS_OFF + NW * 64 * 4;
constexpr int ATT_LDS_BYTES = ATT_BIAS_OFF + 4 * 128 * 4;
constexpr float SCALE = 0.08838834764831845f;
constexpr float THR = 8.f;
constexpr int WBIG = 1 << 30;

#define KSWZ(row, colB) ((row) * 256 + ((colB) ^ (((row) & 7) << 4)))
#define SBAR() __builtin_amdgcn_sched_barrier(0)
__device__ __forceinline__ int v_st(int k, int c) { const int kk = (k & ~0xC) | ((k & 4) << 1) | ((k & 8) >> 1); return ((kk >> 3) * 4 + (c >> 5)) * 512 + ((kk & 7) * 32 + (c & 31)) * 2; }
__device__ __forceinline__ int v_rd_base(int lane) { return ((lane & 3) << 3) | (((lane >> 2) & 3) << 6) | (((lane >> 4) & 1) << 5) | (((lane >> 5) & 1) << 8); }
constexpr int v_rd_off(int d0, int ks, int half) { return d0 * 512 + ks * 4096 + half * 2048; }
__device__ __forceinline__ int crow(int r, int hi) { return (r & 3) + 8 * (r >> 2) + 4 * hi; }
__device__ __forceinline__ unsigned cvtpk(float lo, float hi) { unsigned r; asm volatile("v_cvt_pk_bf16_f32 %0, %1, %2" : "=v"(r) : "v"(lo), "v"(hi)); return r; }
__device__ __forceinline__ bf16x8 load8(const bf16_t* p) { return *reinterpret_cast<const bf16x8*>(p); }

template <bool BIAS>
__device__ __forceinline__ void mask_tile(f32x16& p0, f32x16& p1, int dq, unsigned W, const float* btab) {
    const float NEG = -__builtin_inff();
#pragma unroll
    for (int r = 0; r < 16; ++r) {
        const int c = (r & 3) + 8 * (r >> 2);
        const unsigned d0 = (unsigned)(dq - c), d1 = (unsigned)(dq - c - 32);
        if (d0 >= W) p0[r] = NEG;
        if (d1 >= W) p1[r] = NEG;
    }
}
__device__ __forceinline__ void partialSM(f32x16& p0, f32x16& p1, float& m_reg, float& mn, float& alpha) {
    float pmax = p0[0]; for (int r = 1; r < 16; ++r) pmax = fmaxf(pmax, p0[r]); for (int r = 0; r < 16; ++r) pmax = fmaxf(pmax, p1[r]);
    { auto rr = __builtin_amdgcn_permlane32_swap(__float_as_uint(pmax), __float_as_uint(pmax), false, false);
      pmax = fmaxf(__uint_as_float(rr[0]), __uint_as_float(rr[1])); }
    constexpr float C2 = 1.4426950408889634f * SCALE;
    if (__builtin_expect(__all((pmax - m_reg) * SCALE <= THR), 1)) { mn = m_reg; alpha = 1.f; }
    else { mn = fmaxf(m_reg, pmax); alpha = __builtin_amdgcn_exp2f((m_reg - mn) * C2); m_reg = mn; }
    const float mnL = -mn * C2;
    for (int r = 0; r < 16; ++r) p0[r] = fmaf(p0[r], C2, mnL); for (int r = 0; r < 16; ++r) p1[r] = fmaf(p1[r], C2, mnL);
    for (int r = 0; r < 16; ++r) p0[r] = __builtin_amdgcn_exp2f(p0[r]);
}
__device__ __forceinline__ void finishSM(f32x16& p0, f32x16& p1, float alpha, float& l_reg, bf16x8& pa0, bf16x8& pa1, bf16x8& pa2, bf16x8& pa3) {
    for (int r = 0; r < 16; ++r) p1[r] = __builtin_amdgcn_exp2f(p1[r]);
    float ps = 0; for (int r = 0; r < 16; ++r) ps += p0[r]; for (int r = 0; r < 16; ++r) ps += p1[r];
    { auto rr = __builtin_amdgcn_permlane32_swap(__float_as_uint(ps), __float_as_uint(ps), false, false);
      ps = __uint_as_float(rr[0]) + __uint_as_float(rr[1]); }
    l_reg = l_reg * alpha + ps;
#define PK4(P, B_, OUT) do { unsigned a0 = cvtpk(P[B_+0], P[B_+1]), a1 = cvtpk(P[B_+2], P[B_+3]);                          \
        unsigned b0 = cvtpk(P[B_+4], P[B_+5]), b1 = cvtpk(P[B_+6], P[B_+7]);                                             \
        auto r0 = __builtin_amdgcn_permlane32_swap(a0, b0, false, false); auto r1 = __builtin_amdgcn_permlane32_swap(a1, b1, false, false); \
        u32x4 w = {r0[0], r1[0], r0[1], r1[1]}; OUT = *reinterpret_cast<bf16x8*>(&w); } while (0)
    PK4(p0, 0, pa0); PK4(p0, 8, pa1); PK4(p1, 0, pa2); PK4(p1, 8, pa3);
#undef PK4
}
template <int KB, bool BIAS>
__device__ __forceinline__ void qkt(f32x16& p0, f32x16& p1, const char* K_lds, int r32, int hi, const bf16x8* qr, bool need, int dq, const float* btab) {
    p0 = f32x16{}; p1 = f32x16{};
    if (BIAS && need) {
#pragma unroll
        for (int r = 0; r < 16; ++r) { const int c = (r & 3) + 8 * (r >> 2); const unsigned d0 = (unsigned)(dq - c), d1 = (unsigned)(dq - c - 32);
            p0[r] = btab[d0 < 127u ? d0 : 127u]; p1[r] = btab[d1 < 127u ? d1 : 127u]; }
    }
    const char* kb[4];
#pragma unroll
    for (int dd = 0; dd < 4; ++dd) kb[dd] = K_lds + KB * SHM_K + KSWZ(r32, (dd * 16 + hi * 8) * 2);
#pragma unroll
    for (int d0 = 0; d0 < 8; ++d0) { const char* a = kb[d0 & 3] + (d0 >> 2) * 128;
        bf16x8 b0 = *reinterpret_cast<const bf16x8*>(a);
        bf16x8 b1 = *reinterpret_cast<const bf16x8*>(a + 32 * 256);
        p0 = __builtin_amdgcn_mfma_f32_32x32x16_bf16(b0, qr[d0], p0, 0, 0, 0);
        p1 = __builtin_amdgcn_mfma_f32_32x32x16_bf16(b1, qr[d0], p1, 0, 0, 0); }
}
template <int VB>
__device__ __forceinline__ void pv_tile(f32x16* o, int vb0, bf16x8 pa0, bf16x8 pa1, bf16x8 pa2, bf16x8 pa3) {
#define TRRD(dst, off) asm volatile("ds_read_b64_tr_b16 %0, %1 offset:%2" : "=&v"(dst) : "v"(vb0), "i"(off) : "memory")
#define PV_D0(d0) do { s16x4 l0, l1, l2, l3, h0, h1, h2, h3; constexpr int b_ = VB * SHM_V + v_rd_off(d0, 0, 0); \
        TRRD(l0, b_); TRRD(h0, b_ + 2048); TRRD(l1, b_ + 4096); TRRD(h1, b_ + 6144); TRRD(l2, b_ + 8192); TRRD(h2, b_ + 10240); TRRD(l3, b_ + 12288); TRRD(h3, b_ + 14336); \
        asm volatile("s_waitcnt lgkmcnt(0)" ::: "memory"); SBAR();   \
        o[d0] = __builtin_amdgcn_mfma_f32_32x32x16_bf16(pa0, (bf16x8){l0[0], l0[1], l0[2], l0[3], h0[0], h0[1], h0[2], h0[3]}, o[d0], 0, 0, 0);   \
        o[d0] = __builtin_amdgcn_mfma_f32_32x32x16_bf16(pa1, (bf16x8){l1[0], l1[1], l1[2], l1[3], h1[0], h1[1], h1[2], h1[3]}, o[d0], 0, 0, 0);   \
        o[d0] = __builtin_amdgcn_mfma_f32_32x32x16_bf16(pa2, (bf16x8){l2[0], l2[1], l2[2], l2[3], h2[0], h2[1], h2[2], h2[3]}, o[d0], 0, 0, 0);   \
        o[d0] = __builtin_amdgcn_mfma_f32_32x32x16_bf16(pa3, (bf16x8){l3[0], l3[1], l3[2], l3[3], h3[0], h3[1], h3[2], h3[3]}, o[d0], 0, 0, 0); } while (0)
    PV_D0(0); PV_D0(1); PV_D0(2); PV_D0(3);
#undef PV_D0
#undef TRRD
}

struct BlockRef { const bf16_t* Q; const bf16_t* K; const bf16_t* V; bf16_t* O; int P0; const float* btab; };
struct Seam { bf16x8 qr[8]; bf16x8 st_v0, st_v1, st_k0, st_k1; };
template <int PQ_, int PKV_, int PO_> struct Pitch { static constexpr int q = PQ_, kv = PKV_, o = PO_; };
__device__ __forceinline__ int swa_jlo(int P0, int W) { const int lowk = P0 - W + 1; return lowk > 0 ? lowk / KVBLK : 0; }
#define ROWP(p, k0, rr) ((p) + (size_t)((k0) + (rr)) * PT.kv + sc)
#define VMW() asm volatile("s_waitcnt vmcnt(0)" ::: "memory")
#define VMWN(n) asm volatile("s_waitcnt vmcnt(%0)" :: "i"(n) : "memory")
#define SLOAD_H(Kp, Vp, k0) do { S.st_v0 = load8(ROWP(Vp, k0, sr)); S.st_v1 = load8(ROWP(Vp, k0, 32 + sr));              \
                         S.st_k0 = load8(ROWP(Kp, k0, sr)); S.st_k1 = load8(ROWP(Kp, k0, 32 + sr)); } while (0)
#define SWRITE_HK(bf) do { *(bf16x8*)(K_lds + (bf) * SHM_K + kws) = S.st_k0; *(bf16x8*)(K_lds + (bf) * SHM_K + kws + 32 * 256) = S.st_k1; } while (0)
#define SWRITE_HV(bf) do { *(bf16x8*)(V_lds + (bf) * SHM_V + vst0) = S.st_v0; *(bf16x8*)(V_lds + (bf) * SHM_V + vst1) = S.st_v1; } while (0)
#define SWRITE_H(bf) do { SWRITE_HV(bf); SWRITE_HK(bf); } while (0)
template <class PTt>
__device__ __forceinline__ void attn_prime(const BlockRef& cur, int W, char* lds, Seam& S) {
    constexpr PTt PT{};
    int tid = threadIdx.x; asm volatile("" : "+v"(tid)); const int wid = __builtin_amdgcn_readfirstlane(tid >> 6), lane = tid & 63, r32 = lane & 31, hi = lane >> 5;
    const int sr = tid >> 4, sc = (tid & 15) * 8, kws = KSWZ(sr, sc * 2); char* K_lds = lds + 2 * SHM_V;
    const int kb0 = swa_jlo(cur.P0, W) * KVBLK;
    for (int d0 = 0; d0 < 8; ++d0) S.qr[d0] = load8(cur.Q + (size_t)(wid * QBLK + r32) * PT.q + d0 * 16 + hi * 8);
    SLOAD_H(cur.K, cur.V, kb0); VMW(); SWRITE_HK(0);
    __syncthreads();
}
template <bool BIAS, class PTt>
__device__ __forceinline__ void attn_block(const BlockRef& cur, const BlockRef& nxt, int skv, int W, char* lds, Seam& S) {
    constexpr PTt PT{};
    int tid = threadIdx.x; asm volatile("" : "+v"(tid)); const int wid = __builtin_amdgcn_readfirstlane(tid >> 6), lane = tid & 63, r32 = lane & 31, hi = lane >> 5;
    const int j_lo = swa_jlo(cur.P0, W);
    int j_hi = (cur.P0 + QB - 1) / KVBLK + 1; if (j_hi > skv / KVBLK) j_hi = skv / KVBLK;
    const int NT = j_hi - j_lo;
    const int kbn = swa_jlo(nxt.P0, W) * KVBLK;
    const int qlo = cur.P0 + wid * QBLK, qm = qlo + r32 - 4 * hi;
    char* V_lds = lds; char* K_lds = lds + 2 * SHM_V;
    float* ws = (float*)(lds + ATT_WS_OFF) + wid * 64; float* li_l = ws, * al_l = ws + 32;
    float m_reg = -1e30f, l_reg = 0; f32x16 o[4] = {};
    const int sr = tid >> 4, sc = (tid & 15) * 8, vst0 = v_st(sr, sc), vst1 = v_st(32 + sr, sc), kws = KSWZ(sr, sc * 2);
    const int vb0 = (int)(uintptr_t)V_lds + v_rd_base(lane);
    const bf16_t* Kh = cur.K; const bf16_t* Vh = cur.V; const float* btab = cur.btab;
#define RESC(a) do { if (__any((a) < 1.f)) { if (hi == 0) al_l[r32] = (a); asm volatile("s_waitcnt lgkmcnt(0)" ::: "memory");              \
                     for (int d_ = 0; d_ < 4; ++d_) for (int r = 0; r < 16; ++r) o[d_][r] *= al_l[crow(r, hi)]; } } while (0)
#define KBASE(t) ((j_lo + (t)) * KVBLK)
#define MASKT(P0_, P1_, t) do { const int kb_ = KBASE(t); if (kb_ + KVBLK - 1 > qlo || kb_ <= qlo + QBLK - 1 - W) mask_tile<BIAS>(P0_, P1_, qm - kb_, (unsigned)W, btab); } while (0)
#define NEEDB(t) (BIAS && KBASE(t) + KVBLK - 1 + 113 > qlo)
#define QKT(KB_, PX0, PX1, t) qkt<KB_, BIAS>(PX0, PX1, K_lds, r32, hi, S.qr, NEEDB(t), qm - KBASE(t), btab)
    constexpr int NQL = 8;
#define SEAM_K0() do { VMWN(NQL); SWRITE_HK(0); SBAR(); } while (0)
    f32x16 pA0, pA1, pB0, pB1; float mnA, mnB, alA, alB; bf16x8 pa0, pa1, pa2, pa3;
    SWRITE_HV(0); SBAR();
    if (NT > 1) { SLOAD_H(Kh, Vh, KBASE(1)); }
    SBAR(); QKT(0, pA0, pA1, 0);
    MASKT(pA0, pA1, 0); partialSM(pA0, pA1, m_reg, mnA, alA);
    if (NT > 1) { VMW(); SWRITE_H(1); }
    __syncthreads();
#define HALF_STEP(PX0, PX1, mnX, alX, PY0, PY1, alY, t, KB, VB, SB) do {                                                      \
        SBAR(); QKT(KB, PX0, PX1, (t));                                                                           \
        finishSM(PY0, PY1, alY, l_reg, pa0, pa1, pa2, pa3); SBAR();                                                           \
        if ((t) + 1 < NT) { SLOAD_H(Kh, Vh, KBASE((t) + 1)); SBAR(); }                                                        \
        pv_tile<VB>(o, vb0, pa0, pa1, pa2, pa3); MASKT(PX0, PX1, (t)); partialSM(PX0, PX1, m_reg, mnX, alX);                  \
        __syncthreads();                                                                                                      \
        if ((t) + 1 < NT) { VMW(); SWRITE_H(SB); }                                                                            \
        RESC(alX); __syncthreads(); } while (0)
    for (int t = 1; t + 1 < NT; t += 2) {
        HALF_STEP(pB0, pB1, mnB, alB, pA0, pA1, alA, t, 1, 0, 0);
        HALF_STEP(pA0, pA1, mnA, alA, pB0, pB1, alB, t + 1, 0, 1, 1);
    }
    const bool even = (NT & 1) == 0;
    if (even) { SBAR(); QKT(1, pB0, pB1, NT - 1); SBAR(); }
    SLOAD_H(nxt.K, nxt.V, kbn); SBAR();
#pragma unroll
    for (int d0 = 0; d0 < 8; ++d0) S.qr[d0] = load8(nxt.Q + (size_t)(wid * QBLK + r32) * PT.q + d0 * 16 + hi * 8);
    SBAR();
    finishSM(pA0, pA1, alA, l_reg, pa0, pa1, pa2, pa3); SBAR();
    pv_tile<0>(o, vb0, pa0, pa1, pa2, pa3);
    if (even) { MASKT(pB0, pB1, NT - 1); partialSM(pB0, pB1, m_reg, mnB, alB); __syncthreads(); RESC(alB);
        finishSM(pB0, pB1, alB, l_reg, pa0, pa1, pa2, pa3); SBAR(); pv_tile<1>(o, vb0, pa0, pa1, pa2, pa3); }
    SBAR(); SEAM_K0();
    if (hi == 0) li_l[r32] = l_reg; asm volatile("s_waitcnt lgkmcnt(0)" ::: "memory");
    float rli[16];
#pragma unroll
    for (int r = 0; r < 16; ++r) rli[r] = __builtin_amdgcn_rcpf(li_l[crow(r, hi)]);
    bf16_t* Ow = cur.O + (size_t)(wid * QBLK) * PT.o;
#pragma unroll
    for (int r = 0; r < 16; ++r) { const int orow = crow(r, hi);
#pragma unroll
        for (int d0 = 0; d0 < 4; ++d0) { const float v = o[d0][r] * rli[r];
            const float vn = __shfl_xor(v, 1);
            if ((r32 & 1) == 0) *(unsigned*)(Ow + (size_t)orow * PT.o + d0 * 32 + r32) = cvtpk(v, vn); } }
    __syncthreads();
#undef RESC
#undef KBASE
#undef MASKT
#undef NEEDB
#undef QKT
#undef SEAM_K0
#undef HALF_STEP
}
#undef ROWP
#undef VMW
#undef VMWN
#undef SLOAD_H
#undef SWRITE_HK
#undef SWRITE_HV
#undef SWRITE_H
}

#define XB_TMO      128
#define XB_XCNT(j)  (256  + 64 * (j))
#define XB_XSUB(j)  (1280 + 64 * (j))
#define XB_XGEN(j)  (2304 + 64 * (j))
#define XB_TOP      3328
#define XB_TOPGEN   3392
#define XCD_BAR_WORDS 3456
#define XB_SPIN_CAP (1u << 18)
__device__ __forceinline__ unsigned xb_ld(unsigned* p)              { return __hip_atomic_load(p, __ATOMIC_RELAXED, __HIP_MEMORY_SCOPE_AGENT); }
__device__ __forceinline__ unsigned xb_add(unsigned* p, unsigned v) { return __hip_atomic_fetch_add(p, v, __ATOMIC_RELAXED, __HIP_MEMORY_SCOPE_AGENT); }
__device__ __forceinline__ unsigned xb_xcc_id() { return (unsigned)__builtin_amdgcn_s_getreg((3 << 11) | 20) & 0xFu; }
#define XB_SPIN(cond, bar) do { unsigned _sp = 0; while (cond) { __builtin_amdgcn_s_sleep(1); \
    if ((++_sp & 255u) == 0u) { if (xb_ld(&(bar)[XB_TMO])) break; if (_sp > XB_SPIN_CAP) { atomicAdd(&(bar)[XB_TMO], 1u); break; } } } } while (0)
struct XcdBarrier { unsigned* bar; unsigned x; volatile LAS unsigned* st; };
__device__ __forceinline__ XcdBarrier xcd_barrier_post(unsigned* bar, volatile LAS unsigned* st) {
    XcdBarrier b; b.bar = bar; b.x = xb_xcc_id(); b.st = st;
    if (threadIdx.x == 0) (void)xb_add(&bar[XB_XCNT(b.x)], 1u);
    return b;
}
__device__ __forceinline__ void xcd_barrier_complete(unsigned* bar, unsigned x, unsigned& nloc, unsigned& nx) {
    const unsigned G = gridDim.x * gridDim.y * gridDim.z;
    unsigned sum, cnt, mine, sp = 0u;
    for (;;) {
        sum = 0u; cnt = 0u; mine = 0u;
#pragma unroll
        for (unsigned j = 0; j < 16; ++j) { const unsigned c = xb_ld(&bar[XB_XCNT(j)]); sum += c; cnt += (c > 0u) ? 1u : 0u; mine = (j == x) ? c : mine; }
        if (sum == G) break;
        __builtin_amdgcn_s_sleep(1);
        if ((++sp & 255u) == 0u) { if (xb_ld(&bar[XB_TMO])) break; if (sp > XB_SPIN_CAP) { atomicAdd(&bar[XB_TMO], 1u); break; } }
    }
    nloc = mine > 0u ? mine : 1u; nx = cnt > 0u ? cnt : 1u;
}
__device__ __forceinline__ void xcd_barrier(const XcdBarrier& b) {
    asm volatile("s_waitcnt vmcnt(0)" ::: "memory");
    __syncthreads();
    if (threadIdx.x == 0) {
        unsigned* bar = b.bar;
        __builtin_amdgcn_s_waitcnt(0);
        unsigned nloc = b.st[0], nx = b.st[1];
        if (nloc == 0u) { xcd_barrier_complete(bar, b.x, nloc, nx); b.st[0] = nloc; b.st[1] = nx; }
        const unsigned old = xb_add(&bar[XB_XSUB(b.x)], 1u);
        const unsigned gen = old / nloc;
        if (old + 1u == (gen + 1u) * nloc) {
            __builtin_amdgcn_fence(__ATOMIC_RELEASE, "agent");
            asm volatile("s_waitcnt vmcnt(0)" ::: "memory");
            const unsigned og = xb_add(&bar[XB_TOP], 1u);
            const unsigned tg = og / nx;
            if (og + 1u == (tg + 1u) * nx) xb_add(&bar[XB_TOPGEN], 1u);
            else XB_SPIN(xb_ld(&bar[XB_TOPGEN]) == tg, bar);
            __builtin_amdgcn_fence(__ATOMIC_ACQUIRE, "agent");
            xb_add(&bar[XB_XGEN(b.x)], 1u);
            asm volatile("s_waitcnt vmcnt(0)" ::: "memory");
        } else {
            XB_SPIN(xb_ld(&bar[XB_XGEN(b.x)]) == gen, bar);
            __builtin_amdgcn_fence(__ATOMIC_ACQUIRE, "agent");
            asm volatile("s_waitcnt vmcnt(0)" ::: "memory");
        }
    }
    __syncthreads();
}

struct Params {
    const float* x; const float* mem; const float* t5; const float* w_in; const float* w_conv; const float* dlam; const float* dsub;
    const float* w_branch; const float* w_mix; const float* w_xq; const float* w_xkv; const float* w_xo;
    const float* w_fg; const float* w_fu; const float* w_fd; const float* w_router; const float* w_eg; const float* w_eu; const float* w_ed;
    const float* g_pre_mix; const float* g_post_mix; const float* g_pre_x; const float* g_mem; const float* g_post_x; const float* g_pre_ffn; const float* g_post_ffn;
    float* out; unsigned char* ws; int ph_lo, ph_hi;
};
struct Ctx { int G, c; LAS unsigned char* lds; unsigned char* ws; };
#define TID_INIT() int tid = threadIdx.x; asm volatile("" : "+v"(tid)); const int lane = tid & 63; const int wave = __builtin_amdgcn_readfirstlane(tid >> 6); const int gw = X.c * 8 + wave; const int NGW = X.G * 8; (void)lane; (void)wave; (void)gw; (void)NGW

__device__ __forceinline__ void cvt_item(const float* W, int N, int k0, int n0, bf16_t* dst, size_t dpitch, int drow0, int dcol0, const float* gain, float scale, LAS float* scr, int lane) {
    const int nl = (lane & 15) * 4, kr = lane >> 4;
#pragma unroll 4
    for (int i = 0; i < 16; ++i) { const int kk = 4 * i + kr; const f32x4 v = *(const f32x4*)(W + (size_t)(k0 + kk) * N + n0 + nl);
        const float gs = (gain ? gain[k0 + kk] : 1.0f) * scale;
        LAS float* s = scr + kk * 65 + nl; s[0] = v[0] * gs; s[1] = v[1] * gs; s[2] = v[2] * gs; s[3] = v[3] * gs; }
    LDS_WAIT(); asm volatile("" ::: "memory");
    const int c = lane & 7;
#pragma unroll
    for (int j = 0; j < 8; ++j) { const int n = (lane >> 3) + 8 * j; const LAS float* s = scr + (8 * c) * 65 + n;
        u32x4 o; o.x = pk2(s[0 * 65], s[1 * 65]); o.y = pk2(s[2 * 65], s[3 * 65]); o.z = pk2(s[4 * 65], s[5 * 65]); o.w = pk2(s[6 * 65], s[7 * 65]);
        *(u32x4*)(dst + (size_t)(drow0 + n) * dpitch + dcol0 + k0 + 8 * c) = o; }
    LDS_WAIT(); asm volatile("" ::: "memory");
}
__device__ __forceinline__ void cvt_matrix(const Ctx& X, const float* W, int K, int N, bf16_t* dst, size_t dpitch, int drow0, int dcol0, const float* gain, int scols, float cscale, int rot) {
    TID_INIT();
    LAS float* scr = (LAS float*)(X.lds + wave * 16640);
    const int nnb = N / 64, items = (K / 64) * nnb;
    for (int it = (gw + rot) % NGW; it < items; it += NGW) { const int kb = it / nnb, nb = it % nnb;
        cvt_item(W, N, kb * 64, nb * 64, dst, dpitch, drow0 + nb * 64, dcol0, gain, (nb * 64 < scols) ? cscale : 1.0f, scr, lane); }
}
__device__ __forceinline__ void cvt_gateup(const Ctx& X, const float* Wg, const float* Wu, bf16_t* dst, const float* gain, int rot) {
    TID_INIT();
    LAS float* scr = (LAS float*)(X.lds + wave * 16640);
    constexpr int nrb = 14336 / 64, items = (DM / 64) * nrb;
    for (int it = (gw + rot) % NGW; it < items; it += NGW) { const int kb = it / nrb, rb = it % nrb; const int r0 = rb * 64, pn = r0 >> 8, j0 = r0 & 255;
        const float* W = (j0 < 128) ? Wg : Wu; const int n0 = pn * 128 + (j0 & 127);
        cvt_item(W, DFF, kb * 64, n0, dst, DM, r0, 0, gain, 1.0f, scr, lane); }
}
__device__ __forceinline__ void row_rmsnorm_to_bf16(const float* xrow, bf16_t* orow, int lane) {
    f32x4 v[8]; float s = 0.f;
#pragma unroll
    for (int j = 0; j < 8; ++j) { v[j] = *(const f32x4*)(xrow + j * 256 + lane * 4); s += (v[j][0] * v[j][0] + v[j][1] * v[j][1]) + (v[j][2] * v[j][2] + v[j][3] * v[j][3]); }
    const float rstd = 1.0f / sqrtf(wave_sum(s) * (1.0f / DM) + EPS);
#pragma unroll
    for (int j = 0; j < 8; ++j) { u32x2 w; w.x = pk2(v[j][0] * rstd, v[j][1] * rstd); w.y = pk2(v[j][2] * rstd, v[j][3] * rstd); *(u32x2*)(orow + j * 256 + lane * 4) = w; }
}
__device__ __forceinline__ void phase_prologue(const Ctx& X, const Params& p) {
    TID_INIT();
    unsigned char* ws = X.ws;
    int rot = 0;
    for (int l = 0; l < DEPTH; ++l) {
        cvt_matrix(X, p.w_in + (size_t)l * DM * NIN, DM, NIN, (bf16_t*)(ws + WS_WIN) + (size_t)l * NIN * DM, DM, 0, 0, p.g_pre_mix + l * DM, 1024, 0.08838834764831845f, rot); rot += 331;
        for (int n = 0; n < 3; ++n) { cvt_matrix(X, p.w_branch + ((size_t)l * 3 + n) * 1024 * DM, 1024, DM, (bf16_t*)(ws + WS_WBR) + ((size_t)l * 3 + n) * DM * 1024, 1024, 0, 0, nullptr, 0, 1.0f, rot); rot += 331; }
        cvt_matrix(X, p.w_mix + (size_t)l * DM * DM, DM, DM, (bf16_t*)(ws + WS_WMIX) + (size_t)l * DM * DM, DM, 0, 0, nullptr, 0, 1.0f, rot); rot += 331;
        cvt_matrix(X, p.w_xq + (size_t)l * DM * 512, DM, 512, (bf16_t*)(ws + WS_WXQ) + (size_t)l * 512 * DM, DM, 0, 0, p.g_pre_x + l * DM, 0, 1.0f, rot); rot += 331;
        cvt_matrix(X, p.w_xkv + (size_t)l * DM * 1024, DM, 1024, (bf16_t*)(ws + WS_WXKV), DM, l * 1024, 0, p.g_mem + l * DM, 0, 1.0f, rot); rot += 331;
        cvt_matrix(X, p.w_xo + (size_t)l * 512 * DM, 512, DM, (bf16_t*)(ws + WS_WXO) + (size_t)l * DM * 512, 512, 0, 0, nullptr, 0, 1.0f, rot); rot += 331;
    }
    cvt_gateup(X, p.w_fg, p.w_fu, (bf16_t*)(ws + WS_WGU), p.g_pre_ffn, rot); rot += 331;
    cvt_matrix(X, p.w_fd, DFF, DM, (bf16_t*)(ws + WS_WDN), DFF, 0, 0, nullptr, 0, 1.0f, rot); rot += 331;
    for (int e = 0; e < NEXP; ++e) {
        cvt_gateup(X, p.w_eg + (size_t)e * DM * DFF, p.w_eu + (size_t)e * DM * DFF, (bf16_t*)(ws + WS_WEGU) + (size_t)e * 14336 * DM, p.g_pre_ffn + DM, rot); rot += 331;
        cvt_matrix(X, p.w_ed + (size_t)e * DFF * DM, DFF, DM, (bf16_t*)(ws + WS_WEDN) + (size_t)e * DM * DFF, DFF, 0, 0, nullptr, 0, 1.0f, rot); rot += 331;
    }
    { float* cs = (float*)(ws + WS_ROPE); float* sn = cs + (size_t)S * 64;
      for (int i = X.c * 512 + tid; i < S * 64; i += X.G * 512) { const int pos = i >> 6, k = i & 63;
          const float inv = exp2f(-(float)k * (13.287712379549449f / 64.0f)); const float ang = (float)pos * inv; float sv, cv; sincosf(ang, &sv, &cv); cs[i] = cv; sn[i] = sv; } }
    for (int m = gw; m < MEM_LEN; m += NGW) row_rmsnorm_to_bf16(p.mem + (size_t)m * DM, (bf16_t*)(ws + WS_MEMN) + (size_t)m * DM, lane);
    for (int m = gw; m < S; m += NGW) row_rmsnorm_to_bf16(p.x + (size_t)m * DM, (bf16_t*)(ws + WS_H) + (size_t)m * DM, lane);
}

struct RouteRec { int e1, e2; float g1, g2; int s1, s2, pad0, pad1; };
template <int MODE, bool ROUTE, bool LAST>
__device__ __forceinline__ void phase_norm(const Ctx& X, const float* xsrc, float* xdst, const bf16_t* Y, const float* gpost, bf16_t* H,
                                           const float* w_router, const float* gpre, RouteRec* rr, int* hist) {
    TID_INIT();
    LAS float* wr_l = (LAS float*)X.lds;
    LAS int* cnt_l = (LAS int*)(X.lds + 65536);
    if (ROUTE) {
        for (int i = tid; i < DM * NEXP; i += 512) wr_l[i] = w_router[i] * gpre[i >> 3];
        if (tid < 8) cnt_l[tid] = 0;
        __syncthreads();
    }
    const int rpw = (S + X.G - 1) / X.G;
    for (int ri = wave; ri < rpw; ri += 8) { const int row = X.c * rpw + ri; if (row >= S) break;
        f32x4 xv[8], yv[8]; float s = 0.f;
        float g1 = 0.f, g2 = 0.f; const bf16_t* y1 = Y; const bf16_t* y2 = Y;
        if (MODE == 1) { const RouteRec r = rr[row]; g1 = r.g1; g2 = r.g2; y1 = Y + (size_t)r.s1 * DM; y2 = Y + (size_t)r.s2 * DM; } else { y1 = Y + (size_t)row * DM; }
#pragma unroll
        for (int j = 0; j < 8; ++j) { xv[j] = *(const f32x4*)(xsrc + (size_t)row * DM + j * 256 + lane * 4);
            const u32x2 w = *(const u32x2*)(y1 + j * 256 + lane * 4);
            yv[j] = (f32x4){bf2f(w.x & 0xffffu), bf2f(w.x >> 16), bf2f(w.y & 0xffffu), bf2f(w.y >> 16)};
            if (MODE == 1) { const u32x2 w2 = *(const u32x2*)(y2 + j * 256 + lane * 4);
                yv[j] = yv[j] * g1 + (f32x4){bf2f(w2.x & 0xffffu), bf2f(w2.x >> 16), bf2f(w2.y & 0xffffu), bf2f(w2.y >> 16)} * g2; }
            s += (yv[j][0] * yv[j][0] + yv[j][1] * yv[j][1]) + (yv[j][2] * yv[j][2] + yv[j][3] * yv[j][3]); }
        const float rstd = 1.0f / sqrtf(wave_sum(s) * (1.0f / DM) + EPS); float s2 = 0.f;
#pragma unroll
        for (int j = 0; j < 8; ++j) { const f32x4 g = *(const f32x4*)(gpost + j * 256 + lane * 4); xv[j] = xv[j] + yv[j] * rstd * g;
            *(f32x4*)(xdst + (size_t)row * DM + j * 256 + lane * 4) = xv[j];
            s2 += (xv[j][0] * xv[j][0] + xv[j][1] * xv[j][1]) + (xv[j][2] * xv[j][2] + xv[j][3] * xv[j][3]); }
        if (!LAST) {
            const float rstd2 = 1.0f / sqrtf(wave_sum(s2) * (1.0f / DM) + EPS);
#pragma unroll
            for (int j = 0; j < 8; ++j) { xv[j] = xv[j] * rstd2; u32x2 w; w.x = pk2(xv[j][0], xv[j][1]); w.y = pk2(xv[j][2], xv[j][3]); *(u32x2*)(H + (size_t)row * DM + j * 256 + lane * 4) = w; }
            if (ROUTE) {
                float lg[8] = {0.f, 0.f, 0.f, 0.f, 0.f, 0.f, 0.f, 0.f};
#pragma unroll
                for (int j = 0; j < 8; ++j)
#pragma unroll
                    for (int q = 0; q < 4; ++q) { const int k = j * 256 + lane * 4 + q; const f32x4 a = *(const LAS f32x4*)(wr_l + k * 8), b = *(const LAS f32x4*)(wr_l + k * 8 + 4); const float xx = xv[j][q];
                        lg[0] += xx * a[0]; lg[1] += xx * a[1]; lg[2] += xx * a[2]; lg[3] += xx * a[3]; lg[4] += xx * b[0]; lg[5] += xx * b[1]; lg[6] += xx * b[2]; lg[7] += xx * b[3]; }
#pragma unroll
                for (int e = 0; e < 8; ++e) lg[e] = wave_sum(lg[e]);
                int e1 = 0; float v1 = lg[0];
#pragma unroll
                for (int e = 1; e < 8; ++e) if (lg[e] > v1) { v1 = lg[e]; e1 = e; }
                int e2 = -1; float v2 = -__builtin_inff();
#pragma unroll
                for (int e = 0; e < 8; ++e) if (e != e1 && lg[e] > v2) { v2 = lg[e]; e2 = e; }
                const float ex = __expf(v2 - v1); const float ga = 1.0f / (1.0f + ex), gb = ex / (1.0f + ex);
                if (lane == 0) { RouteRec r; r.e1 = e1; r.e2 = e2; r.g1 = ga; r.g2 = gb; r.s1 = 0; r.s2 = 0; r.pad0 = 0; r.pad1 = 0; rr[row] = r; atomicAdd((int*)cnt_l + e1, 1); atomicAdd((int*)cnt_l + e2, 1); }
            }
        }
    }
    if (ROUTE) { __syncthreads(); if (tid < 8) hist[X.c * 8 + tid] = cnt_l[tid]; }
}

__device__ __forceinline__ void phase_assign(const Ctx& X, RouteRec* rr, const int* hist, int* tstart_g, int* slottok) {
    TID_INIT();
    LAS int* hl = (LAS int*)X.lds;
    LAS int* base_l = hl + 4096;
    LAS int* seg_l = base_l + 8;
    for (int i = tid; i < X.G * 8; i += 512) hl[i] = hist[i];
    __syncthreads();
    if (tid < 8) { int tot = 0, before = 0; for (int c = 0; c < X.G; ++c) { const int v = hl[c * 8 + tid]; if (c < X.c) before += v; tot += v; } seg_l[16 + tid] = tot; base_l[tid] = before; }
    __syncthreads();
    if (tid == 0) { int t = 0; for (int e = 0; e < 8; ++e) { seg_l[e] = t * 256; if (X.c == 0) tstart_g[e] = t; t += (seg_l[16 + e] + 255) >> 8; } seg_l[8] = t * 256; if (X.c == 0) tstart_g[8] = t; }
    __syncthreads();
    const int rpw = (S + X.G - 1) / X.G;
    if (tid < 8) { const int e = tid; int pos = seg_l[e] + base_l[e];
        for (int ri = 0; ri < rpw; ++ri) { const int row = X.c * rpw + ri; if (row >= S) break;
            const int e1 = rr[row].e1, e2 = rr[row].e2;
            if (e1 == e) { rr[row].s1 = pos; slottok[pos] = row; ++pos; }
            if (e2 == e) { rr[row].s2 = pos; slottok[pos] = row; ++pos; } } }
    if (X.c < 8) { const int e = X.c; const int lo = seg_l[e] + seg_l[16 + e], hi = seg_l[e + 1]; for (int i = lo + tid; i < hi; i += 512) slottok[i] = 0; }
}

__device__ __forceinline__ void unpack8(const u32x4 w, float (&f)[8]) {
    f[0] = bf2f(w.x & 0xffffu); f[1] = bf2f(w.x >> 16); f[2] = bf2f(w.y & 0xffffu); f[3] = bf2f(w.y >> 16);
    f[4] = bf2f(w.z & 0xffffu); f[5] = bf2f(w.z >> 16); f[6] = bf2f(w.w & 0xffffu); f[7] = bf2f(w.w >> 16);
}
__device__ __forceinline__ void phase_conv(const Ctx& X, const bf16_t* P, const float* wconv, bf16_t* Y3) {
    TID_INIT();
    for (int it = X.c * 512 + tid; it < S * 128; it += X.G * 512) { const int t = it >> 7, w0 = (it & 127) * 8;
        float acc[8] = {0.f, 0.f, 0.f, 0.f, 0.f, 0.f, 0.f, 0.f};
#pragma unroll
        for (int j = 0; j < 3; ++j) { const int tt = t - 2 + j; if (tt < 0) continue;
            float c[8], u[8]; unpack8(*(const u32x4*)(P + (size_t)tt * NIN + C_CC + w0), c); unpack8(*(const u32x4*)(P + (size_t)tt * NIN + C_CU + w0), u);
            const f32x4 wa = *(const f32x4*)(wconv + j * 1024 + w0), wb = *(const f32x4*)(wconv + j * 1024 + w0 + 4);
#pragma unroll
            for (int q = 0; q < 4; ++q) { acc[q] += wa[q] * c[q] * u[q]; acc[4 + q] += wb[q] * c[4 + q] * u[4 + q]; } }
        float b[8]; unpack8(*(const u32x4*)(P + (size_t)t * NIN + C_CB + w0), b);
        u32x4 o; o.x = pk2(b[0] * acc[0], b[1] * acc[1]); o.y = pk2(b[2] * acc[2], b[3] * acc[3]); o.z = pk2(b[4] * acc[4], b[5] * acc[5]); o.w = pk2(b[6] * acc[6], b[7] * acc[7]);
        *(u32x4*)(Y3 + (size_t)S * 1024 + (size_t)t * 1024 + w0) = o; }
}

__device__ __forceinline__ int tr_addr(int lane, int pitch) { const int g = lane >> 4, i = lane & 15; return ((g >> 1) * 8 + (i >> 2)) * pitch + ((g & 1) * 16 + (i & 3) * 4) * 2; }
#define TR_READ2(lo, hi, addr, off_lo, off_hi) do { asm volatile("ds_read_b64_tr_b16 %0, %1 offset:%2" : "=&v"(lo) : "v"(addr), "i"(off_lo) : "memory"); \
                                                     asm volatile("ds_read_b64_tr_b16 %0, %1 offset:%2" : "=&v"(hi) : "v"(addr), "i"(off_hi) : "memory"); } while (0)
constexpr int RP_T = 320;
constexpr int RP_R = 272;
__device__ __forceinline__ float ret_logg(int h) { return log1pf(-exp2f(-5.0f - (float)h)); }
__device__ __forceinline__ void rope8(const u32x4 w1, const u32x4 w2, const float* cs, const float* sn, float scale, u32x4& o1, u32x4& o2) {
    float a[8], b[8]; unpack8(w1, a); unpack8(w2, b);
    const f32x4 c0 = *(const f32x4*)cs, c1 = *(const f32x4*)(cs + 4), s0 = *(const f32x4*)sn, s1 = *(const f32x4*)(sn + 4);
    float r1[8], r2[8];
#pragma unroll
    for (int q = 0; q < 4; ++q) { r1[q] = (a[q] * c0[q] - b[q] * s0[q]) * scale; r2[q] = (a[q] * s0[q] + b[q] * c0[q]) * scale;
        r1[4 + q] = (a[4 + q] * c1[q] - b[4 + q] * s1[q]) * scale; r2[4 + q] = (a[4 + q] * s1[q] + b[4 + q] * c1[q]) * scale; }
    o1.x = pk2(r1[0], r1[1]); o1.y = pk2(r1[2], r1[3]); o1.z = pk2(r1[4], r1[5]); o1.w = pk2(r1[6], r1[7]);
    o2.x = pk2(r2[0], r2[1]); o2.y = pk2(r2[2], r2[3]); o2.z = pk2(r2[4], r2[5]); o2.w = pk2(r2[6], r2[7]);
}
__device__ __forceinline__ void phase_ret_kv(const Ctx& X, const bf16_t* P, const float* rope_cs, float* KVS) {
    LAS unsigned char* kd_l = X.lds;
    LAS unsigned char* v_l = X.lds + 128 * RP_T;
    TID_INIT();
    const float* rope_sn = rope_cs + (size_t)S * 64;
    const int w = wave, r32 = lane & 31, hi = lane >> 5;
    for (int u = X.c; u < 1024; u += X.G) { const int n = u >> 3, h = u & 7, t0 = n * 128; const float lg = ret_logg(h);
#pragma unroll
        for (int ii = 0; ii < 2; ++ii) { const int pi = tid + 512 * ii, j = pi >> 3, d0 = (pi & 7) * 8; const bf16_t* kp = P + (size_t)(t0 + j) * NIN + C_RK + h * 128 + d0;
            u32x4 o1, o2; rope8(*(const u32x4*)kp, *(const u32x4*)(kp + 64), rope_cs + (size_t)(t0 + j) * 64 + d0, rope_sn + (size_t)(t0 + j) * 64 + d0, __expf((float)(127 - j) * lg), o1, o2);
            *(LAS u32x4*)(kd_l + j * RP_T + d0 * 2) = o1; *(LAS u32x4*)(kd_l + j * RP_T + (d0 + 64) * 2) = o2; }
#pragma unroll
        for (int ii = 0; ii < 4; ++ii) { const int pi = tid + 512 * ii, j = pi >> 4, e0 = (pi & 15) * 8;
            *(LAS u32x4*)(v_l + j * RP_T + e0 * 2) = *(const u32x4*)(P + (size_t)(t0 + j) * NIN + C_RV + h * 128 + e0); }
        LDS_WAIT(); __syncthreads();
        const int db = w >> 1, eb0 = (w & 1) * 2;
        f32x16 c0 = {}, c1 = {};
        const int ta = (int)(uintptr_t)(kd_l) + tr_addr(lane, RP_T) + db * 64, tb = (int)(uintptr_t)(v_l) + tr_addr(lane, RP_T) + eb0 * 64;
#define RKV_STEP(ks) do { s16x4 al, ah, bl0, bh0, bl1, bh1; \
            TR_READ2(al, ah, ta, (ks) * 16 * RP_T, (ks) * 16 * RP_T + 4 * RP_T); TR_READ2(bl0, bh0, tb, (ks) * 16 * RP_T, (ks) * 16 * RP_T + 4 * RP_T); TR_READ2(bl1, bh1, tb, (ks) * 16 * RP_T + 64, (ks) * 16 * RP_T + 4 * RP_T + 64); \
            LDS_WAIT(); __builtin_amdgcn_sched_barrier(0); \
            const bf16x8 af = {al[0], al[1], al[2], al[3], ah[0], ah[1], ah[2], ah[3]}; \
            c0 = __builtin_amdgcn_mfma_f32_32x32x16_bf16(af, (bf16x8){bl0[0], bl0[1], bl0[2], bl0[3], bh0[0], bh0[1], bh0[2], bh0[3]}, c0, 0, 0, 0); \
            c1 = __builtin_amdgcn_mfma_f32_32x32x16_bf16(af, (bf16x8){bl1[0], bl1[1], bl1[2], bl1[3], bh1[0], bh1[1], bh1[2], bh1[3]}, c1, 0, 0, 0); } while (0)
        RKV_STEP(0); RKV_STEP(1); RKV_STEP(2); RKV_STEP(3); RKV_STEP(4); RKV_STEP(5); RKV_STEP(6); RKV_STEP(7);
#undef RKV_STEP
        float* outp = KVS + (size_t)u * 16384;
#pragma unroll
        for (int r = 0; r < 16; ++r) { const int d = db * 32 + att::crow(r, hi); outp[d * 128 + eb0 * 32 + r32] = c0[r]; outp[d * 128 + (eb0 + 1) * 32 + r32] = c1[r]; }
        __syncthreads();
    }
}
__device__ __forceinline__ void phase_ret_scan(const Ctx& X, const float* KVS, bf16_t* PRV) {
    TID_INIT();
    for (int idx = X.c * 512 + tid; idx < 8 * 16384; idx += X.G * 512) { const int h = idx >> 14, ed = idx & 16383; const float cd = __expf(128.0f * ret_logg(h));
        float st = 0.f;
        for (int n0 = 0; n0 < 128; n0 += 8) { float kv[8];
#pragma unroll
            for (int q = 0; q < 8; ++q) kv[q] = KVS[((size_t)((n0 + q) * 8 + h) << 14) + ed];
#pragma unroll
            for (int q = 0; q < 8; ++q) { PRV[((size_t)((n0 + q) * 8 + h) << 14) + ed] = (bf16_t)f2bf(st); st = st * cd + kv[q]; } } }
}
__device__ __forceinline__ void phase_ret_out(const Ctx& X, const bf16_t* P, const float* rope_cs, const bf16_t* PRV, bf16_t* Y3) {
    LAS unsigned char* q_l = X.lds;
    LAS unsigned char* k_l = X.lds + 128 * RP_R;
    LAS unsigned char* v_l = X.lds + 2 * 128 * RP_R;
    LAS unsigned char* s_l = v_l + 128 * RP_T;
    LAS float* o_l = (LAS float*)X.lds;
    static_assert(2 * 128 * RP_R + 2 * 128 * RP_T <= LDS_CTL_OFF && 128 * 132 * 4 <= 2 * 128 * RP_R, "retention LDS map");
    TID_INIT();
    const float* rope_sn = rope_cs + (size_t)S * 64;
    const int w = wave, r32 = lane & 31, hi = lane >> 5;
    for (int u = X.c; u < 1024; u += X.G) { const int n = u >> 3, h = u & 7, t0 = n * 128; const float lg = ret_logg(h);
#pragma unroll
        for (int ii = 0; ii < 2; ++ii) { const int pi = tid + 512 * ii, j = pi >> 3, d0 = (pi & 7) * 8; const size_t ro = (size_t)(t0 + j) * NIN + h * 128 + d0;
            const float* cs = rope_cs + (size_t)(t0 + j) * 64 + d0; const float* sn = rope_sn + (size_t)(t0 + j) * 64 + d0; u32x4 o1, o2;
            rope8(*(const u32x4*)(P + ro + C_RQ), *(const u32x4*)(P + ro + C_RQ + 64), cs, sn, 1.0f, o1, o2);
            *(LAS u32x4*)(q_l + j * RP_R + d0 * 2) = o1; *(LAS u32x4*)(q_l + j * RP_R + (d0 + 64) * 2) = o2;
            rope8(*(const u32x4*)(P + ro + C_RK), *(const u32x4*)(P + ro + C_RK + 64), cs, sn, 1.0f, o1, o2);
            *(LAS u32x4*)(k_l + j * RP_R + d0 * 2) = o1; *(LAS u32x4*)(k_l + j * RP_R + (d0 + 64) * 2) = o2; }
#pragma unroll
        for (int ii = 0; ii < 4; ++ii) { const int pi = tid + 512 * ii, j = pi >> 4, e0 = (pi & 15) * 8;
            *(LAS u32x4*)(v_l + j * RP_T + e0 * 2) = *(const u32x4*)(P + (size_t)(t0 + j) * NIN + C_RV + h * 128 + e0);
            *(LAS u32x4*)(s_l + j * RP_T + e0 * 2) = *(const u32x4*)(PRV + (size_t)u * 16384 + j * 128 + e0); }
        LDS_WAIT(); __syncthreads();
        const int ib = w >> 1, jb0 = (w & 1) * 2;
        f32x16 s0 = {}, s1 = {};
#pragma unroll
        for (int ks = 0; ks < 8; ++ks) { const bf16x8 a = *(const LAS bf16x8*)(q_l + (ib * 32 + r32) * RP_R + (ks * 16 + hi * 8) * 2);
            const bf16x8 b0 = *(const LAS bf16x8*)(k_l + (jb0 * 32 + r32) * RP_R + (ks * 16 + hi * 8) * 2), b1 = *(const LAS bf16x8*)(k_l + ((jb0 + 1) * 32 + r32) * RP_R + (ks * 16 + hi * 8) * 2);
            s0 = __builtin_amdgcn_mfma_f32_32x32x16_bf16(a, b0, s0, 0, 0, 0); s1 = __builtin_amdgcn_mfma_f32_32x32x16_bf16(a, b1, s1, 0, 0, 0); }
        __syncthreads();
#pragma unroll
        for (int r = 0; r < 16; ++r) { const int i = ib * 32 + att::crow(r, hi); const int j0 = jb0 * 32 + r32, j1 = j0 + 32;
            const float p0 = (i >= j0) ? s0[r] * __expf((float)(i - j0) * lg) : 0.f, p1 = (i >= j1) ? s1[r] * __expf((float)(i - j1) * lg) : 0.f;
            *(LAS bf16_t*)(k_l + i * RP_R + j0 * 2) = (bf16_t)f2bf(p0); *(LAS bf16_t*)(k_l + i * RP_R + j1 * 2) = (bf16_t)f2bf(p1); }
        LDS_WAIT(); __syncthreads();
        const int eb0 = (w & 1) * 2;
        f32x16 a0 = {}, a1 = {}, x0 = {}, x1 = {};
        const int tv = (int)(uintptr_t)(v_l) + tr_addr(lane, RP_T) + eb0 * 64, tsx = (int)(uintptr_t)(s_l) + tr_addr(lane, RP_T) + eb0 * 64;
#define ROUT_STEP(ks) do { s16x4 bl0, bh0, bl1, bh1, cl0, ch0, cl1, ch1; \
            TR_READ2(bl0, bh0, tv, (ks) * 16 * RP_T, (ks) * 16 * RP_T + 4 * RP_T); TR_READ2(bl1, bh1, tv, (ks) * 16 * RP_T + 64, (ks) * 16 * RP_T + 4 * RP_T + 64); \
            TR_READ2(cl0, ch0, tsx, (ks) * 16 * RP_T, (ks) * 16 * RP_T + 4 * RP_T); TR_READ2(cl1, ch1, tsx, (ks) * 16 * RP_T + 64, (ks) * 16 * RP_T + 4 * RP_T + 64); \
            const bf16x8 pa = *(const LAS bf16x8*)(k_l + (ib * 32 + r32) * RP_R + ((ks) * 16 + hi * 8) * 2), qa = *(const LAS bf16x8*)(q_l + (ib * 32 + r32) * RP_R + ((ks) * 16 + hi * 8) * 2); \
            LDS_WAIT(); __builtin_amdgcn_sched_barrier(0); \
            a0 = __builtin_amdgcn_mfma_f32_32x32x16_bf16(pa, (bf16x8){bl0[0], bl0[1], bl0[2], bl0[3], bh0[0], bh0[1], bh0[2], bh0[3]}, a0, 0, 0, 0); \
            a1 = __builtin_amdgcn_mfma_f32_32x32x16_bf16(pa, (bf16x8){bl1[0], bl1[1], bl1[2], bl1[3], bh1[0], bh1[1], bh1[2], bh1[3]}, a1, 0, 0, 0); \
            x0 = __builtin_amdgcn_mfma_f32_32x32x16_bf16(qa, (bf16x8){cl0[0], cl0[1], cl0[2], cl0[3], ch0[0], ch0[1], ch0[2], ch0[3]}, x0, 0, 0, 0); \
            x1 = __builtin_amdgcn_mfma_f32_32x32x16_bf16(qa, (bf16x8){cl1[0], cl1[1], cl1[2], cl1[3], ch1[0], ch1[1], ch1[2], ch1[3]}, x1, 0, 0, 0); } while (0)
        ROUT_STEP(0); ROUT_STEP(1); ROUT_STEP(2); ROUT_STEP(3); ROUT_STEP(4); ROUT_STEP(5); ROUT_STEP(6); ROUT_STEP(7);
#undef ROUT_STEP
        __syncthreads();
#pragma unroll
        for (int r = 0; r < 16; ++r) { const int i = ib * 32 + att::crow(r, hi); const float qd = __expf((float)(i + 1) * lg);
            o_l[i * 132 + eb0 * 32 + r32] = a0[r] + qd * x0[r]; o_l[i * 132 + (eb0 + 1) * 32 + r32] = a1[r] + qd * x1[r]; }
        LDS_WAIT(); __syncthreads();
        for (int ri = 0; ri < 16; ++ri) { const int i = w * 16 + ri; const f32x2 v = *(const LAS f32x2*)(o_l + i * 132 + lane * 2);
            const float rstd = 1.0f / sqrtf(wave_sum(v[0] * v[0] + v[1] * v[1]) * (1.0f / 128.0f) + EPS);
            const unsigned gw = *(const unsigned*)(P + (size_t)(t0 + i) * NIN + C_RG + h * 128 + lane * 2);
            *(unsigned*)(Y3 + (size_t)(t0 + i) * 1024 + h * 128 + lane * 2) = pk2(bf2f(gw & 0xffffu) * v[0] * rstd, bf2f(gw >> 16) * v[1] * rstd); }
        __syncthreads();
    }
}

__device__ __forceinline__ void phase_diff_combine(const Ctx& X, const bf16_t* OT, const float* dlam, const float* dsub, float lam_init, bf16_t* Y3) {
    TID_INIT();
    float d1 = dlam[lane] * dlam[128 + lane] + dlam[64 + lane] * dlam[128 + 64 + lane];
    float d2 = dlam[256 + lane] * dlam[384 + lane] + dlam[256 + 64 + lane] * dlam[384 + 64 + lane];
    const float lam = __expf(wave_sum(d1)) - __expf(wave_sum(d2)) + lam_init;
    const f32x4 sg = *(const f32x4*)(dsub + lane * 4);
    for (int it = gw; it < S * 4; it += NGW) { const int t = it >> 2, h = it & 3;
        const u32x2 w0 = *(const u32x2*)(OT + (size_t)t * 2048 + h * 512 + lane * 4), w1 = *(const u32x2*)(OT + (size_t)t * 2048 + h * 512 + 256 + lane * 4);
        f32x4 o = (f32x4){bf2f(w0.x & 0xffffu), bf2f(w0.x >> 16), bf2f(w0.y & 0xffffu), bf2f(w0.y >> 16)} - (f32x4){bf2f(w1.x & 0xffffu), bf2f(w1.x >> 16), bf2f(w1.y & 0xffffu), bf2f(w1.y >> 16)} * lam;
        const float rstd = 1.0f / sqrtf(wave_sum((o[0] * o[0] + o[1] * o[1]) + (o[2] * o[2] + o[3] * o[3])) * (1.0f / 256.0f) + EPS) * (1.0f - lam_init);
        o = o * rstd * sg; u32x2 w; w.x = pk2(o[0], o[1]); w.y = pk2(o[2], o[3]);
        *(u32x2*)(Y3 + (size_t)2 * S * 1024 + (size_t)t * 1024 + h * 256 + lane * 4) = w; }
}

__device__ __forceinline__ att::BlockRef diff_ref(const bf16_t* P, bf16_t* OT, const float* bias_l, int L, int pass) {
    const int vh = (L & 7) | ((L >> 8) << 3), x = (L >> 3) & 31, qb = pass ? 63 - x : x; const int h = vh >> 2, m = (vh >> 1) & 1, vf = vh & 1;
    att::BlockRef r; const size_t ro = (size_t)qb * 256 * NIN;
    r.Q = P + ro + C_DQ + h * 256 + m * 128; r.K = P + C_DK + h * 256 + m * 128; r.V = P + C_DV + h * 256 + vf * 128;
    r.O = OT + (size_t)qb * 256 * 2048 + h * 512 + m * 256 + vf * 128; r.P0 = qb * 256; r.btab = bias_l + h * 128; return r;
}
__device__ __forceinline__ void phase_diff_attn(const Ctx& X, const bf16_t* P, bf16_t* OT, const float* t5) {
    TID_INIT();
    char* lds = (char*)X.lds; float* bias_l = (float*)(lds + att::ATT_BIAS_OFF);
    { const int h = tid >> 7, d = tid & 127; int b = d; if (d >= 16) { b = 16 + (int)(logf((float)d * (1.0f / 16.0f)) / logf(8.0f) * 16.0f); if (b > 31) b = 31; }
      bias_l[h * 128 + d] = (t5[b * 4 + h] - t5[31 * 4 + h]) * (1.0f / att::SCALE); }
    __syncthreads();
    typedef att::Pitch<NIN, NIN, 2048> PT;
    int L = X.c; if (L >= 512) return;
    int pass = 0; att::BlockRef cur = diff_ref(P, OT, bias_l, L, 0); att::Seam Sm;
    att::attn_prime<PT>(cur, att::WBIG, lds, Sm);
    for (;;) {
        const bool more_pass = pass == 0, more_item = L + X.G < 512, last = !more_pass && !more_item;
        int Ln = L, passn = pass + 1; if (!more_pass) { passn = 0; Ln = more_item ? L + X.G : L; }
        const att::BlockRef nxt = last ? cur : diff_ref(P, OT, bias_l, Ln, passn);
        att::attn_block<true, PT>(cur, nxt, S, att::WBIG, lds, Sm);
        if (last) break;
        cur = nxt; pass = passn; L = Ln;
    }
}
__device__ __forceinline__ att::BlockRef xattn_ref(const bf16_t* QX, const bf16_t* KVX, bf16_t* OX, int l, int L) {
    const int h = L & 3, qb = L >> 2; att::BlockRef r;
    r.Q = QX + (size_t)qb * 256 * 512 + h * 128; r.K = KVX + l * 1024 + h * 128; r.V = KVX + l * 1024 + 512 + h * 128; r.O = OX + (size_t)qb * 256 * 512 + h * 128; r.P0 = 1 << 20; r.btab = nullptr; return r;
}
__device__ __forceinline__ void phase_xattn(const Ctx& X, const bf16_t* QX, const bf16_t* KVX, bf16_t* OX, int l) {
    char* lds = (char*)X.lds; typedef att::Pitch<512, 2048, 512> PT;
    int L = X.c; if (L >= 256) return;
    att::BlockRef cur = xattn_ref(QX, KVX, OX, l, L); att::Seam Sm;
    att::attn_prime<PT>(cur, att::WBIG, lds, Sm);
    for (;;) {
        const bool last = L + X.G >= 256; const int Ln = last ? L : L + X.G;
        const att::BlockRef nxt = last ? cur : xattn_ref(QX, KVX, OX, l, Ln);
        att::attn_block<false, PT>(cur, nxt, MEM_LEN, att::WBIG, lds, Sm);
        if (last) break;
        cur = nxt; L = Ln;
    }
}

constexpr int PH_PER_LAYER = 15, N_PHASES = 1 + DEPTH * PH_PER_LAYER;
__global__ void __launch_bounds__(512, 2) trunk_fwd(Params p) {
    extern __shared__ __attribute__((aligned(16))) unsigned char smem[];
    Ctx X; X.G = gridDim.x; X.c = blockIdx.x; X.lds = (LAS unsigned char*)smem; X.ws = p.ws;
    unsigned char* ws = p.ws;
    volatile LAS unsigned* ctl_l = (volatile LAS unsigned*)(X.lds + LDS_CTL_OFF);
    if (threadIdx.x < 32) ctl_l[threadIdx.x] = 0u;
    __syncthreads();
#if ONE_LAUNCH
    XcdBarrier bar = xcd_barrier_post((unsigned*)(ws + WS_CTL), ctl_l);
#define IN0 true
#define IN(j) true
#define SEAM() xcd_barrier(bar)
#define LAYER_LOOP for (int l = 0; l < DEPTH; ++l)
#else
    const int slot = p.ph_hi;
#define IN0 (slot == 15)
#define IN(j) (slot == (j))
#define SEAM() do { } while (0)
#define LAYER_LOOP const int l = p.ph_lo;
#endif
    bf16_t* const P = (bf16_t*)(ws + WS_P); bf16_t* const H = (bf16_t*)(ws + WS_H); bf16_t* const Y = (bf16_t*)(ws + WS_Y); bf16_t* const Y3 = (bf16_t*)(ws + WS_Y3);
    bf16_t* const OT = (bf16_t*)(ws + WS_OT); bf16_t* const MG = (bf16_t*)(ws + WS_MG); bf16_t* const QX = (bf16_t*)(ws + WS_QX); bf16_t* const OX = (bf16_t*)(ws + WS_OX);
    bf16_t* const YS = (bf16_t*)(ws + WS_YS); float* const KVS = (float*)(ws + WS_KVS); bf16_t* const PRV = (bf16_t*)(ws + WS_PRV);
    bf16_t* const KVX = (bf16_t*)(ws + WS_KVX); const float* const ROPE = (const float*)(ws + WS_ROPE);
    RouteRec* const RR = (RouteRec*)(ws + WS_ROUTE); int* const SLOTTOK = (int*)(ws + WS_SLOTTOK); int* const HIST = (int*)(ws + WS_HIST); int* const TSTART = HIST + 4096;

    if (IN0) { phase_prologue(X, p); }
    SEAM();
    LAYER_LOOP {
        if (IN(0)) {
            if (l == 0) { pg8::Gemm g{(const bf16_t*)(ws + WS_MEMN), (const bf16_t*)(ws + WS_WXKV), MEM_LEN, 2048, DM, 0, 0}; pg8::StaticOrder So; So.init(MEM_LEN, 2048, X.G, X.c);
                pg8::EpiStore<0> E{KVX, 2048}; pg8::gemm_phase(X.lds, g, So, E); }
            pg8::Gemm g{H, (const bf16_t*)(ws + WS_WIN) + (size_t)l * NIN * DM, S, NIN, DM, 0, 0}; pg8::StaticOrder So; So.init(S, NIN, X.G, X.c);
            pg8::EpiStore<1> E{P, NIN}; pg8::gemm_phase(X.lds, g, So, E);
        }
        SEAM();
        if (IN(1)) {
            phase_ret_kv(X, P, ROPE, KVS);
            phase_conv(X, P, p.w_conv + l * 3 * 1024, Y3);
            __syncthreads();
            phase_diff_attn(X, P, OT, p.t5);
        }
        SEAM();
        if (IN(2)) {
            phase_ret_scan(X, KVS, PRV);
            phase_diff_combine(X, OT, p.dlam + l * 512, p.dsub + l * 256, 0.8f - 0.6f * __expf(-0.3f * (float)l), Y3);
        }
        SEAM();
        if (IN(3)) { phase_ret_out(X, P, ROPE, PRV, Y3); }
        SEAM();
        if (IN(4)) {
            pg8::Gemm g{Y3, (const bf16_t*)(ws + WS_WBR) + (size_t)l * 3 * DM * 1024, S, DM, 1024, (size_t)DM * 1024 * 2, (size_t)S * 1024 * 2}; pg8::MergeOrder So; So.init(S, DM, X.G, X.c);
            pg8::EpiMerge E{MG, DM, P + C_GL, NIN}; pg8::gemm_phase(X.lds, g, So, E);
        }
        SEAM();
        if (IN(5)) {
            pg8::Gemm g{MG, (const bf16_t*)(ws + WS_WMIX) + (size_t)l * DM * DM, S, DM, DM, 0, 0}; pg8::StaticOrder So; So.init(S, DM, X.G, X.c);
            pg8::EpiStore<0> E{Y, DM}; pg8::gemm_phase(X.lds, g, So, E);
        }
        SEAM();
        if (IN(6)) { phase_norm<0, false, false>(X, l == 0 ? p.x : p.out, p.out, Y, p.g_post_mix + l * DM, H, nullptr, nullptr, nullptr, nullptr); }
        SEAM();
        if (IN(7)) {
            pg8::Gemm g{H, (const bf16_t*)(ws + WS_WXQ) + (size_t)l * 512 * DM, S, 512, DM, 0, 0}; pg8::StaticOrder So; So.init(S, 512, X.G, X.c);
            pg8::EpiStore<0> E{QX, 512}; pg8::gemm_phase(X.lds, g, So, E);
        }
        SEAM();
        if (IN(8)) { phase_xattn(X, QX, KVX, OX, l); }
        SEAM();
        if (IN(9)) {
            pg8::Gemm g{OX, (const bf16_t*)(ws + WS_WXO) + (size_t)l * DM * 512, S, DM, 512, 0, 0}; pg8::StaticOrder So; So.init(S, DM, X.G, X.c);
            pg8::EpiStore<0> E{Y, DM}; pg8::gemm_phase(X.lds, g, So, E);
        }
        SEAM();
        if (IN(10)) {
            if (l == 0) phase_norm<0, false, false>(X, p.out, p.out, Y, p.g_post_x + l * DM, H, nullptr, nullptr, nullptr, nullptr);
            else phase_norm<0, true, false>(X, p.out, p.out, Y, p.g_post_x + l * DM, H, p.w_router, p.g_pre_ffn + DM, RR, HIST);
        }
        SEAM();
        if (l == 0) {
            if (IN(11)) {
                pg8::Gemm g{H, (const bf16_t*)(ws + WS_WGU), S, 2 * DFF, DM, 0, 0}; pg8::StaticOrder So; So.init(S, 2 * DFF, X.G, X.c);
                pg8::EpiSwiglu E{P, DFF}; pg8::gemm_phase(X.lds, g, So, E);
            }
            SEAM();
            if (IN(12)) {
                pg8::Gemm g{P, (const bf16_t*)(ws + WS_WDN), S, DM, DFF, 0, 0}; pg8::StaticOrder So; So.init(S, DM, X.G, X.c);
                pg8::EpiStore<0> E{Y, DM}; pg8::gemm_phase(X.lds, g, So, E);
            }
            SEAM();
            if (IN(13)) { phase_norm<0, false, false>(X, p.out, p.out, Y, p.g_post_ffn + l * DM, H, nullptr, nullptr, nullptr, nullptr); }
            SEAM();
        } else {
            if (IN(11)) { phase_assign(X, RR, HIST, TSTART, SLOTTOK); }
            SEAM();
            if (IN(12)) {
                pg8::Gemm g{H, (const bf16_t*)(ws + WS_WEGU), 0, 2 * DFF, DM, (size_t)14336 * DM * 2, 0}; pg8::MoeOrder<true> So; So.init(TSTART, 2 * DFF, X.G, X.c, SLOTTOK);
                pg8::EpiSwiglu E{P, DFF}; pg8::gemm_phase(X.lds, g, So, E);
            }
            SEAM();
            if (IN(13)) {
                pg8::Gemm g{P, (const bf16_t*)(ws + WS_WEDN), 0, DM, DFF, (size_t)DM * DFF * 2, 0}; pg8::MoeOrder<false> So; So.init(TSTART, DM, X.G, X.c, nullptr);
                pg8::EpiStore<0> E{YS, DM}; pg8::gemm_phase(X.lds, g, So, E);
            }
            SEAM();
            if (IN(14)) { phase_norm<1, false, true>(X, p.out, p.out, YS, p.g_post_ffn + l * DM, nullptr, nullptr, nullptr, RR, nullptr); }
        }
    }
#undef IN
#undef IN0
#undef SEAM
#undef LAYER_LOOP
}

extern "C" void kernel_launch(void* const* d_in, const int* in_sizes, int n_in, void* d_out, int out_size, void* d_ws, size_t ws_size, hipStream_t stream) {
    static int grid = 0;
    if (grid == 0) {
        if (n_in != 26 || out_size != S * DM || ws_size < WS_END) { fprintf(stderr, "kernel_launch: unexpected shapes (n_in %d out %d ws %zu)\n", n_in, out_size, ws_size); grid = -1; return; }
        int dev = 0, cus = 0, per_cu = 0;
        if (hipGetDevice(&dev) != hipSuccess || hipDeviceGetAttribute(&cus, hipDeviceAttributeMultiprocessorCount, dev) != hipSuccess) { grid = -1; return; }
        if (hipFuncSetAttribute((const void*)trunk_fwd, hipFuncAttributeMaxDynamicSharedMemorySize, LDS_BYTES) != hipSuccess) { fprintf(stderr, "kernel_launch: hipFuncSetAttribute failed\n"); grid = -1; return; }
        if (hipOccupancyMaxActiveBlocksPerMultiprocessor(&per_cu, (const void*)trunk_fwd, 512, LDS_BYTES) != hipSuccess || per_cu < 1) { fprintf(stderr, "kernel_launch: occupancy query says %d\n", per_cu); (void)hipGetLastError(); grid = -1; return; }
        grid = cus;
    }
    if (grid < 0) return;
    (void)hipMemsetAsync((char*)d_ws + WS_CTL, 0, CTL_ZERO_BYTES, stream);
    Params p{};
    const float** f = (const float**)&p;
    for (int i = 0; i < 26; ++i) f[i] = (const float*)d_in[i];
    p.out = (float*)d_out; p.ws = (unsigned char*)d_ws;
#if ONE_LAUNCH
    p.ph_lo = 0; p.ph_hi = 0;
    hipLaunchKernelGGL(trunk_fwd, dim3(grid), dim3(512), LDS_BYTES, stream, p);
#else
    p.ph_lo = 0; p.ph_hi = 15; hipLaunchKernelGGL(trunk_fwd, dim3(grid), dim3(512), LDS_BYTES, stream, p);
    for (int l = 0; l < DEPTH; ++l) for (int j = 0; j < 15; ++j) { if (l == 0 && j == 14) continue;
        p.ph_lo = l; p.ph_hi = j; hipLaunchKernelGGL(trunk_fwd, dim3(grid), dim3(512), LDS_BYTES, stream, p); }
#endif
}
```

```cpp
#include <hip/hip_runtime.h>
#include <cstdio>
#include <cstdint>

#ifndef ONE_LAUNCH
#define ONE_LAUNCH 1
#endif

#define LAS __attribute__((address_space(3)))
typedef unsigned short bf16_t;
typedef short bf16x8 __attribute__((ext_vector_type(8)));
typedef short s16x4 __attribute__((ext_vector_type(4)));
typedef float f32x4 __attribute__((ext_vector_type(4)));
typedef float f32x2 __attribute__((ext_vector_type(2)));
typedef float f32x16 __attribute__((ext_vector_type(16)));
typedef unsigned u32x4 __attribute__((ext_vector_type(4)));
typedef unsigned u32x2 __attribute__((ext_vector_type(2)));

constexpr int S = 16384, DM = 2048, DEPTH = 2, MEM_LEN = 256;
constexpr int NIN = 16384;
constexpr int NIN16 = 10240, NIN8 = NIN - NIN16;
constexpr int C_RQ = 0, C_RK = 1024, C_RV = 2048, C_RG = 3072, C_CB = 4096, C_CC = 5120, C_CU = 6144, C_DQ = 7168, C_DK = 8192, C_DV = 9216, C_GL = 10240;
constexpr int DFF = 7168, NEXP = 8;
constexpr float EPS = 1e-6f;
constexpr float WSC8 = 32.0f;
constexpr int MOE_MAXROWS = 2 * S + NEXP * 256;
__host__ __device__ __forceinline__ size_t pidx(int row, int col) { return ((size_t)(col >> 8) * S + (size_t)row) * 256 + (size_t)(col & 255); }

constexpr size_t MiB = 1u << 20;
constexpr size_t WS_CTL = 0, CTL_ZERO_BYTES = 64 * 1024;
constexpr size_t WS_KVX = 1 * MiB;
constexpr size_t WS_MEMN = 2 * MiB;
constexpr size_t WS_ROUTE = 3 * MiB;
constexpr size_t WS_SLOTTOK = 4 * MiB;
constexpr size_t WS_HIST = 5 * MiB;
constexpr size_t WS_ROPE = 6 * MiB;
constexpr size_t WS_W = 16 * MiB;
constexpr size_t WS_WIN = WS_W;
constexpr size_t WS_WIN8 = WS_WIN + 80 * MiB;
constexpr size_t WS_WBR = WS_WIN + 128 * MiB;
constexpr size_t WS_WMIX = WS_WBR + 24 * MiB;
constexpr size_t WS_WXQ = WS_WMIX + 16 * MiB;
constexpr size_t WS_WXKV = WS_WXQ + 4 * MiB;
constexpr size_t WS_WXO = WS_WXKV + 8 * MiB;
constexpr size_t WS_WGU = WS_WXO + 4 * MiB;
constexpr size_t WS_WDN = WS_WGU + 56 * MiB;
constexpr size_t WS_WEGU = WS_WDN + 28 * MiB;
constexpr size_t WS_WEDN = WS_WEGU + 224 * MiB;
constexpr size_t WS_P = WS_WEDN + 112 * MiB;
constexpr size_t WS_H = WS_P + 512 * MiB;
constexpr size_t WS_Y = WS_H + 64 * MiB;
constexpr size_t WS_Y3 = WS_Y + 64 * MiB;
constexpr size_t WS_OT = WS_Y3 + 96 * MiB;
constexpr size_t WS_MG = WS_OT + 64 * MiB;
constexpr size_t WS_QX = WS_MG, WS_OX = WS_MG + 16 * MiB;
constexpr size_t WS_YS = WS_MG + 64 * MiB;
constexpr size_t WS_KVS = WS_YS, WS_PRV = WS_YS + 64 * MiB;
constexpr size_t WS_H8 = WS_YS + 136 * MiB;
constexpr size_t WS_END = WS_H8 + 32 * MiB;
static_assert(WS_END <= (size_t)2010 * MiB, "workspace map exceeds the guaranteed size");

constexpr int LDS_BYTES = 163840;
constexpr int LDS_CTL_OFF = 163328;

__device__ __forceinline__ float bf2f(unsigned b) { return __uint_as_float(b << 16); }
__device__ __forceinline__ unsigned f2bf(float f) { unsigned u = __float_as_uint(f); return (u + 0x7fffu + ((u >> 16) & 1u)) >> 16; }
__device__ __forceinline__ unsigned pk2(float lo, float hi) { return f2bf(lo) | (f2bf(hi) << 16); }
__device__ __forceinline__ unsigned cvt_pk_bf16(float lo, float hi) { unsigned r; asm volatile("v_cvt_pk_bf16_f32 %0, %1, %2" : "=v"(r) : "v"(lo), "v"(hi)); return r; }
__device__ __forceinline__ float wave_sum(float v) {
    v += __int_as_float(__builtin_amdgcn_ds_swizzle(__float_as_int(v), 0x041F));
    v += __int_as_float(__builtin_amdgcn_ds_swizzle(__float_as_int(v), 0x081F));
    v += __int_as_float(__builtin_amdgcn_ds_swizzle(__float_as_int(v), 0x101F));
    v += __int_as_float(__builtin_amdgcn_ds_swizzle(__float_as_int(v), 0x201F));
    v += __int_as_float(__builtin_amdgcn_ds_swizzle(__float_as_int(v), 0x401F));
    const auto rr = __builtin_amdgcn_permlane32_swap(__float_as_uint(v), __float_as_uint(v), false, false);
    return __uint_as_float(rr[0]) + __uint_as_float(rr[1]);
}
__device__ __forceinline__ float fast_sigmoid(float x) { return __builtin_amdgcn_rcpf(1.0f + __builtin_amdgcn_exp2f(-1.4426950408889634f * x)); }
__device__ __forceinline__ float clamp8(float v) { return __builtin_fminf(__builtin_fmaxf(v, -448.0f), 448.0f); }
__device__ __forceinline__ unsigned pk4_fp8(float a, float b, float c, float d) { int v = 0; v = __builtin_amdgcn_cvt_pk_fp8_f32(clamp8(a), clamp8(b), v, false); v = __builtin_amdgcn_cvt_pk_fp8_f32(clamp8(c), clamp8(d), v, true); return (unsigned)v; }
__device__ __forceinline__ int lane_id_opaque() { int l = (int)__builtin_amdgcn_mbcnt_hi(~0u, __builtin_amdgcn_mbcnt_lo(~0u, 0u)); asm volatile("" : "+v"(l)); return l; }
#define LDS_WAIT() asm volatile("s_waitcnt lgkmcnt(0)" ::: "memory")
#define VM_WAIT() asm volatile("s_waitcnt vmcnt(0)" ::: "memory")

namespace pg8 {
constexpr bool PG8_SP2 = true;
constexpr int BM = 256, BK = 64, HALF = 128, HTB = HALF * BK * 2, STAGE_BYTES = 8 * HTB, NXCD = 8, WGM = 8;
__host__ __device__ __forceinline__ int lds_byte(int r, int c) { const int st = (r >> 4) * 2 + (c >> 5), rr = r & 15, cc = c & 31, ob = rr * 64 + cc * 2; return st * 1024 + (ob ^ (((ob >> 9) & 1) << 5)); }
__host__ __device__ __forceinline__ void stage_rc(int b, int& R, int& C) { const int st = b / 1024, sb = b % 1024, swz = sb ^ (((sb >> 9) & 1) << 5); R = (st >> 1) * 16 + swz / 64; C = (st & 1) * 32 + (swz % 64) / 2; }
__host__ __device__ __forceinline__ int perm32(int rho) { const int n = rho >> 4, i = rho & 15; return 8 * (i >> 2) + 4 * n + (i & 3); }

struct Unit { int pm, pn, e, ko, aux; };
struct Gemm { const bf16_t* A; const bf16_t* Bt; int M, N, K; size_t bstride, astride; int ld = 0; };

struct StaticOrder {
    static constexpr bool GATHER = false;
    int nM, nN, nwg, G, c;
    __device__ __forceinline__ void init(int M, int N, int G_, int c_) { nM = M / BM; nN = N / BM; nwg = nM * nN; G = G_; c = c_; }
    __device__ __forceinline__ bool next(int i, Unit& u) const {
        const long L = (long)i * G + c; if (L >= nwg) return false;
        int wgid = (int)L; { const int q = nwg / NXCD, r = nwg % NXCD, xcd = wgid % NXCD, off = wgid / NXCD; wgid = (xcd < r ? xcd * (q + 1) : r * (q + 1) + (xcd - r) * q) + off; }
        const int nig = WGM * nN, gid = wgid / nig, fm = gid * WGM, gsz = (nM - fm) < WGM ? (nM - fm) : WGM;
        u.pm = fm + ((wgid % nig) % gsz); u.pn = (wgid % nig) / gsz; u.e = 0; u.ko = 0; u.aux = 0; return true;
    }
    __device__ __forceinline__ int tok(int) const { return 0; }
};
template <bool GATH> struct MoeOrder {
    static constexpr bool GATHER = GATH;
    int nM, nN, nwg, G, c, lim; int ts1, ts2, ts3, ts4, ts5, ts6, ts7; const int* tokp;
    __device__ __forceinline__ void init(const int* tstart, int N, int G_, int c_, const int* tokp_) {
        nM = tstart[8]; nN = N / BM; nwg = nM * nN; lim = nwg; G = G_; c = c_; tokp = tokp_;
        ts1 = tstart[1]; ts2 = tstart[2]; ts3 = tstart[3]; ts4 = tstart[4]; ts5 = tstart[5]; ts6 = tstart[6]; ts7 = tstart[7];
    }
    __device__ __forceinline__ void unit_of(int L, Unit& u) const {
        int wgid = L; { const int q = nwg / NXCD, r = nwg % NXCD, xcd = wgid % NXCD, off = wgid / NXCD; wgid = (xcd < r ? xcd * (q + 1) : r * (q + 1) + (xcd - r) * q) + off; }
        const int nig = WGM * nN, gid = wgid / nig, fm = gid * WGM, gsz = (nM - fm) < WGM ? (nM - fm) : WGM;
        u.pm = fm + ((wgid % nig) % gsz); u.pn = (wgid % nig) / gsz; u.ko = 0; u.aux = 0;
        u.e = (u.pm >= ts1) + (u.pm >= ts2) + (u.pm >= ts3) + (u.pm >= ts4) + (u.pm >= ts5) + (u.pm >= ts6) + (u.pm >= ts7);
    }
    __device__ __forceinline__ bool next(int i, Unit& u) const {
        const long L = (long)i * G + c; if (L >= lim) return false;
        unit_of((int)L, u); return true;
    }
    __device__ __forceinline__ int tok(int row) const { return tokp[row]; }
};

template <int MODE> struct EpiStore {
    static constexpr bool MID = false;
    bf16_t* O; int ldc; float scale;
    __device__ __forceinline__ bool operator()(f32x4 (&acc)[2][2][4][2], const Unit& u, int wr, int wc, int fr, int fq) const {
        const int row0 = u.pm * BM + wr * 64 + fr, col0 = u.pn * BM + wc * 32 + 8 * fq;
        const int act = (MODE == 1) ? ((u.pn >= 12 && u.pn < 16) ? 1 : (u.pn >= 40 ? 2 : 0)) : (MODE == 2 ? 2 : 0);
        const int ptile = (MODE == 2) ? u.pn + 40 : u.pn;
#pragma unroll
        for (int ai = 0; ai < 2; ++ai)
#pragma unroll
            for (int m = 0; m < 4; ++m) { bf16_t* rowp = (MODE != 0) ? O + ((size_t)ptile * S + (size_t)(row0 + ai * HALF + m * 16)) * 256 + (wc * 32 + 8 * fq) : O + (size_t)(row0 + ai * HALF + m * 16) * ldc + col0;
#pragma unroll
                for (int bj = 0; bj < 2; ++bj) { f32x4 v0 = acc[ai][bj][m][0] * scale, v1 = acc[ai][bj][m][1] * scale;
                    if (MODE != 0 && act != 0) {
#pragma unroll
                        for (int j = 0; j < 4; ++j) { const float s0 = fast_sigmoid(v0[j]), s1 = fast_sigmoid(v1[j]);
                            v0[j] = (act == 1) ? v0[j] * s0 : fmaxf(s0, 1e-6f); v1[j] = (act == 1) ? v1[j] * s1 : fmaxf(s1, 1e-6f); } }
                    u32x4 w; w.x = cvt_pk_bf16(v0[0], v0[1]); w.y = cvt_pk_bf16(v0[2], v0[3]); w.z = cvt_pk_bf16(v1[0], v1[1]); w.w = cvt_pk_bf16(v1[2], v1[3]);
                    *(u32x4*)(rowp + bj * HALF) = w; } }
        return false;
    }
};
struct EpiSwiglu {
    static constexpr bool MID = false;
    bf16_t* O; int ldc;
    __device__ __forceinline__ bool operator()(f32x4 (&acc)[2][2][4][2], const Unit& u, int wr, int wc, int fr, int fq) const {
        const int row0 = u.pm * BM + wr * 64 + fr, col0 = u.pn * HALF + wc * 32 + 8 * fq;
#pragma unroll
        for (int ai = 0; ai < 2; ++ai)
#pragma unroll
            for (int m = 0; m < 4; ++m) { bf16_t* rowp = O + (size_t)(row0 + ai * HALF + m * 16) * ldc + col0;
                f32x4 v0, v1;
#pragma unroll
                for (int j = 0; j < 4; ++j) { const float g0 = acc[ai][0][m][0][j], g1 = acc[ai][0][m][1][j];
                    v0[j] = g0 * fast_sigmoid(g0) * acc[ai][1][m][0][j]; v1[j] = g1 * fast_sigmoid(g1) * acc[ai][1][m][1][j]; }
                u32x4 w; w.x = cvt_pk_bf16(v0[0], v0[1]); w.y = cvt_pk_bf16(v0[2], v0[3]); w.z = cvt_pk_bf16(v1[0], v1[1]); w.w = cvt_pk_bf16(v1[2], v1[3]);
                *(u32x4*)rowp = w; }
        return false;
    }
};
struct EpiMerge {
    static constexpr bool MID = false;
    bf16_t* O; int ldc; const bf16_t* G; int ldg;
    __device__ __forceinline__ void unp(const u32x4 w, float (&g)[8]) const {
        g[0] = bf2f(w.x & 0xffffu); g[1] = bf2f(w.x >> 16); g[2] = bf2f(w.y & 0xffffu); g[3] = bf2f(w.y >> 16);
        g[4] = bf2f(w.z & 0xffffu); g[5] = bf2f(w.z >> 16); g[6] = bf2f(w.w & 0xffffu); g[7] = bf2f(w.w >> 16);
    }
    __device__ __forceinline__ bool operator()(f32x4 (&acc)[2][2][4][2], const Unit& u, int wr, int wc, int fr, int fq) const {
        const int row0 = u.pm * BM + wr * 64 + fr, col0 = u.pn * BM + wc * 32 + 8 * fq;
        if (u.e < 2) {
#pragma unroll
            for (int ai = 0; ai < 2; ++ai) { u32x4 ga[4][2], gb[4][2];
#pragma unroll
                for (int m = 0; m < 4; ++m) { const bf16_t* gp = G + ((size_t)(40 + u.e * 8 + u.pn) * S + (size_t)(row0 + ai * HALF + m * 16)) * 256 + (wc * 32 + 8 * fq);
#pragma unroll
                    for (int bj = 0; bj < 2; ++bj) { ga[m][bj] = *(const u32x4*)(gp + bj * HALF); gb[m][bj] = *(const u32x4*)(gp + bj * HALF + (size_t)8 * S * 256); } }
                asm volatile("" ::: "memory");
#pragma unroll
                for (int m = 0; m < 4; ++m)
#pragma unroll
                    for (int bj = 0; bj < 2; ++bj) { float a[8], b[8]; unp(ga[m][bj], a); unp(gb[m][bj], b);
#pragma unroll
                        for (int j = 0; j < 4; ++j) { acc[ai][bj][m][0][j] *= a[j] * __builtin_amdgcn_rcpf(b[j]); acc[ai][bj][m][1][j] *= a[4 + j] * __builtin_amdgcn_rcpf(b[4 + j]); } }
                asm volatile("" : "+v"(acc[ai][0][0][0]), "+v"(acc[ai][1][0][0]) :: "memory"); }
            return true;
        }
#pragma unroll
        for (int ai = 0; ai < 2; ++ai) { u32x4 gc[4][2];
#pragma unroll
            for (int m = 0; m < 4; ++m) { const bf16_t* gp = G + ((size_t)(40 + 16 + u.pn) * S + (size_t)(row0 + ai * HALF + m * 16)) * 256 + (wc * 32 + 8 * fq);
#pragma unroll
                for (int bj = 0; bj < 2; ++bj) gc[m][bj] = *(const u32x4*)(gp + bj * HALF); }
            asm volatile("" ::: "memory");
#pragma unroll
            for (int m = 0; m < 4; ++m) { bf16_t* rowp = O + (size_t)(row0 + ai * HALF + m * 16) * ldc + col0;
#pragma unroll
                for (int bj = 0; bj < 2; ++bj) { float c[8]; unp(gc[m][bj], c); const f32x4 v0 = acc[ai][bj][m][0], v1 = acc[ai][bj][m][1];
                    u32x4 w; w.x = cvt_pk_bf16(v0[0] * c[0], v0[1] * c[1]); w.y = cvt_pk_bf16(v0[2] * c[2], v0[3] * c[3]); w.z = cvt_pk_bf16(v1[0] * c[4], v1[1] * c[5]); w.w = cvt_pk_bf16(v1[2] * c[6], v1[3] * c[7]);
                    *(u32x4*)(rowp + bj * HALF) = w; } }
            asm volatile("" ::: "memory"); }
        return false;
    }
};
struct EpiSwiglu8 {
    static constexpr bool MID = false;
    unsigned char* O; int ldc; float scale;
    __device__ __forceinline__ bool operator()(f32x4 (&acc)[2][2][4][2], const Unit& u, int wr, int wc, int fr, int fq) const {
        const int row0 = u.pm * BM + wr * 64 + fr, col0 = u.pn * HALF + wc * 32 + 8 * fq;
#pragma unroll
        for (int ai = 0; ai < 2; ++ai)
#pragma unroll
            for (int m = 0; m < 4; ++m) { unsigned char* rowp = O + (size_t)(row0 + ai * HALF + m * 16) * ldc + col0;
                f32x4 v0, v1;
#pragma unroll
                for (int j = 0; j < 4; ++j) { const float g0 = acc[ai][0][m][0][j] * scale, g1 = acc[ai][0][m][1][j] * scale;
                    v0[j] = g0 * fast_sigmoid(g0) * (acc[ai][1][m][0][j] * scale); v1[j] = g1 * fast_sigmoid(g1) * (acc[ai][1][m][1][j] * scale); }
                u32x2 w; w.x = pk4_fp8(v0[0], v0[1], v0[2], v0[3]); w.y = pk4_fp8(v1[0], v1[1], v1[2], v1[3]);
                *(u32x2*)rowp = w; }
        return false;
    }
};
struct MergeOrder {
    static constexpr bool GATHER = false;
    StaticOrder so;
    __device__ __forceinline__ void init(int M, int N, int G_, int c_) { so.init(M, N, G_, c_); }
    __device__ __forceinline__ bool next(int i, Unit& u) const { const int q = i / 3; if (!so.next(q, u)) return false; u.e = i - 3 * q; return true; }
    __device__ __forceinline__ int tok(int) const { return 0; }
};

struct MoeTailOrder {
    static constexpr bool GATHER = false;
    static constexpr int NSL = 7, SLB = 1024;
    MoeOrder<false> mo; int first, nsub;
    __device__ __forceinline__ void init(const int* tstart, int N, int G_, int c_, int first_, int T) { mo.init(tstart, N, G_, c_, nullptr); first = first_; nsub = T * NSL; }
    __device__ __forceinline__ bool next(int i, Unit& u) const { const int idx = i * mo.G + mo.c; if (idx >= nsub) return false;
        const int j = idx / NSL, ks = idx - j * NSL; mo.unit_of(first + j, u); u.ko = ks * SLB; u.aux = idx; return true; }
    __device__ __forceinline__ int tok(int) const { return 0; }
};
struct EpiPart {
    static constexpr bool MID = false;
    bf16_t* O; float scale;
    __device__ __forceinline__ bool operator()(f32x4 (&acc)[2][2][4][2], const Unit& u, int wr, int wc, int fr, int fq) const {
        bf16_t* base = O + ((size_t)u.aux << 16) + (size_t)(wr * 64 + fr) * 256 + wc * 32 + 8 * fq;
#pragma unroll
        for (int ai = 0; ai < 2; ++ai)
#pragma unroll
            for (int m = 0; m < 4; ++m) { bf16_t* rowp = base + (size_t)(ai * HALF + m * 16) * 256;
#pragma unroll
                for (int bj = 0; bj < 2; ++bj) { const f32x4 v0 = acc[ai][bj][m][0] * scale, v1 = acc[ai][bj][m][1] * scale;
                    u32x4 w; w.x = cvt_pk_bf16(v0[0], v0[1]); w.y = cvt_pk_bf16(v0[2], v0[3]); w.z = cvt_pk_bf16(v1[0], v1[1]); w.w = cvt_pk_bf16(v1[2], v1[3]);
                    *(u32x4*)(rowp + bj * HALF) = w; } }
        return false;
    }
};

template <class Epi, class Sched, bool FP8 = false>
__device__ __forceinline__ void gemm_phase(LAS unsigned char* lds, const Gemm g, const Sched& S, const Epi& E, const int wid) {
    const int lane = lane_id_opaque(), tid = (wid << 6) | lane;
    const int wr = wid >> 2, wc = wid & 3, fr = lane & 15, fq = lane >> 4;
    const int K = g.K, nt = K / BK, LD = g.ld ? g.ld : K;
    unsigned voffA[2], voffB[2];
#pragma unroll
    for (int i = 0; i < 2; ++i) { int R, C; stage_rc(tid * 16 + i * 8192, R, C); const int Rb = (R & ~31) + perm32(R & 31);
        voffA[i] = (unsigned)(R * LD + C) * 2u; voffB[i] = (unsigned)(Rb * LD + C) * 2u; }
    const size_t kstep = (size_t)(BK * 2);
    const size_t hstep = (size_t)HALF * LD * 2;
    const size_t tstep = 2 * hstep;
    const unsigned ldsw = (unsigned)wid * 1024u;
    const int aoff = lds_byte(wr * 64 + fr, fq * 8), boff = lds_byte(wc * 32 + fr, fq * 8);
#define PG8_SA(b, h) (((b) * 2 + (h)) * HTB)
#define PG8_SB(b, h) ((4 + (b) * 2 + (h)) * HTB)
#define PG8_STAGE(bufoff, gbase, voff) do { _Pragma("unroll") for (int _i = 0; _i < 2; ++_i) \
        __builtin_amdgcn_global_load_lds((const unsigned*)((const char*)(gbase) + (voff)[_i]), (LAS unsigned*)(lds + (bufoff) + ldsw + _i * 8192), 16, 0, 0); } while (0)
#define PG8_STAGE_A(bufoff, nx, h, kt) do { if constexpr (Sched::GATHER) { unsigned _o[2]; _o[0] = (nx) ? ngofs[h][0] : gofs[h][0]; _o[1] = (nx) ? ngofs[h][1] : gofs[h][1]; \
            PG8_STAGE(bufoff, (const char*)g.A + (size_t)(kt) * kstep, _o); } \
        else { PG8_STAGE(bufoff, ((nx) ? nA : cA) + (size_t)(h) * hstep + (size_t)(kt) * kstep, voffA); } } while (0)
#define PG8_LDA(dst, b, h) do { _Pragma("unroll") for (int m = 0; m < 4; ++m) _Pragma("unroll") for (int k = 0; k < 2; ++k) dst[m][k] = *(const LAS bf16x8*)(lds + PG8_SA(b, h) + aoff + m * 2048 + k * 1024); } while (0)
#define PG8_LDB(dst, b, h) do { _Pragma("unroll") for (int n = 0; n < 2; ++n) _Pragma("unroll") for (int k = 0; k < 2; ++k) dst[n][k] = *(const LAS bf16x8*)(lds + PG8_SB(b, h) + boff + n * 2048 + k * 1024); } while (0)
#define PG8_MMA(ai, bj, At, Bt) do { if constexpr (!FP8) __builtin_amdgcn_s_setprio(1); _Pragma("unroll") for (int m = 0; m < 4; ++m) _Pragma("unroll") for (int n = 0; n < 2; ++n) { \
        if constexpr (FP8) { typedef int i32x8 __attribute__((ext_vector_type(8))); typedef int i32x4 __attribute__((ext_vector_type(4))); \
            const i32x4 b0_ = __builtin_bit_cast(i32x4, Bt[n][0]), b1_ = __builtin_bit_cast(i32x4, Bt[n][1]), a0_ = __builtin_bit_cast(i32x4, At[m][0]), a1_ = __builtin_bit_cast(i32x4, At[m][1]); \
            const i32x8 b8_ = {b0_[0], b0_[1], b0_[2], b0_[3], b1_[0], b1_[1], b1_[2], b1_[3]}, a8_ = {a0_[0], a0_[1], a0_[2], a0_[3], a1_[0], a1_[1], a1_[2], a1_[3]}; \
            asm volatile("v_mfma_f32_16x16x128_f8f6f4 %0, %1, %2, %0" : "+v"(acc[ai][bj][m][n]) : "v"(b8_), "v"(a8_)); } \
        else { _Pragma("unroll") for (int k = 0; k < 2; ++k) acc[ai][bj][m][n] = __builtin_amdgcn_mfma_f32_16x16x32_bf16(Bt[n][k], At[m][k], acc[ai][bj][m][n], 0, 0, 0); } } \
        if constexpr (!FP8) __builtin_amdgcn_s_setprio(0); } while (0)
#define PG8_WAIT_V(n) asm volatile("s_waitcnt vmcnt(" #n ")" ::: "memory")
#define PG8_WAIT_L(n) asm volatile("s_waitcnt lgkmcnt(" #n ")" ::: "memory")
#define PG8_BAR __builtin_amdgcn_s_barrier()
#define PG8_SCHED __builtin_amdgcn_sched_barrier(0)
#define PG8_GOFS(dst, u_) do { _Pragma("unroll") for (int _h = 0; _h < 2; ++_h) _Pragma("unroll") for (int _i = 0; _i < 2; ++_i) \
        { int _R, _C; stage_rc(tid * 16 + _i * 8192, _R, _C); dst[_h][_i] = (unsigned)(S.tok((u_).pm * BM + _h * HALF + _R) * K + _C) * 2u; } } while (0)
    int sc8 = 0x7F7F7F7F; asm volatile("" : "+v"(sc8)); (void)sc8;
    Unit cur, nxt; int ui = 0;
    if (!S.next(0, cur)) return;
    f32x4 acc[2][2][4][2];
#pragma unroll
    for (int a = 0; a < 2; ++a)
#pragma unroll
        for (int b = 0; b < 2; ++b)
#pragma unroll
            for (int m = 0; m < 4; ++m)
#pragma unroll
                for (int n = 0; n < 2; ++n) acc[a][b][m][n] = (f32x4){0.f, 0.f, 0.f, 0.f};
    bf16x8 At[4][2], B0[2][2], B1[2][2];
    unsigned gofs[2][2] = {{0u, 0u}, {0u, 0u}}, ngofs[2][2] = {{0u, 0u}, {0u, 0u}};
    if constexpr (Sched::GATHER) { PG8_GOFS(gofs, cur); }
    const char* cA = (const char*)g.A + (Sched::GATHER ? (size_t)0 : (size_t)cur.pm * tstep + (size_t)cur.e * g.astride + (size_t)cur.ko); const char* nA = cA;
    const char* cB = (const char*)g.Bt + (size_t)cur.e * g.bstride + (size_t)cur.pn * tstep + (size_t)cur.ko;
    if constexpr (PG8_SP2) {
    PG8_STAGE(PG8_SB(0, 0), cB, voffB); PG8_STAGE(PG8_SB(0, 1), cB + hstep, voffB); PG8_STAGE_A(PG8_SA(0, 0), false, 0, 0); PG8_STAGE_A(PG8_SA(0, 1), false, 1, 0);
    if (wr == 1) PG8_BAR;
    PG8_WAIT_V(2); PG8_BAR;
    PG8_STAGE(PG8_SB(1, 0), cB + kstep, voffB); PG8_STAGE_A(PG8_SA(1, 0), false, 0, 1); PG8_STAGE(PG8_SB(1, 1), cB + hstep + kstep, voffB);
    PG8_WAIT_V(6); PG8_BAR;
    } else {
    PG8_STAGE(PG8_SB(0, 0), cB, voffB); PG8_STAGE_A(PG8_SA(0, 0), false, 0, 0); PG8_STAGE(PG8_SB(0, 1), cB + hstep, voffB); PG8_STAGE_A(PG8_SA(0, 1), false, 1, 0);
    if (wr == 1) PG8_BAR;
    PG8_WAIT_V(4); PG8_BAR;
    PG8_STAGE(PG8_SB(1, 0), cB + kstep, voffB); PG8_STAGE_A(PG8_SA(1, 0), false, 0, 1); PG8_STAGE(PG8_SB(1, 1), cB + hstep + kstep, voffB);
    PG8_WAIT_V(6); PG8_BAR;
    }
    for (;;) {
        const bool has_next = S.next(ui + 1, nxt);
        if constexpr (Sched::GATHER) { if (has_next) { PG8_GOFS(ngofs, nxt); } else { _Pragma("unroll") for (int _h = 0; _h < 2; ++_h) _Pragma("unroll") for (int _i = 0; _i < 2; ++_i) ngofs[_h][_i] = gofs[_h][_i]; } }
        else { nA = has_next ? (const char*)g.A + (size_t)nxt.pm * tstep + (size_t)nxt.e * g.astride + (size_t)nxt.ko : cA; }
        const char* nB = has_next ? (const char*)g.Bt + (size_t)nxt.e * g.bstride + (size_t)nxt.pn * tstep + (size_t)nxt.ko : cB;
        for (int t = 0; t < nt; t += 2) {
            const bool last = (t == nt - 2);
            const char* b2 = last ? nB : cB + (size_t)(t + 2) * kstep; const char* b3 = b2 + kstep;
            const int kt2 = last ? 0 : t + 2, kt3 = kt2 + 1;
            if constexpr (PG8_SP2) {
            PG8_LDB(B0, 0, 0); PG8_LDB(B1, 0, 1); PG8_SCHED; PG8_LDA(At, 0, 0); PG8_STAGE_A(PG8_SA(1, 1), false, 1, t + 1);
            PG8_WAIT_V(8); PG8_WAIT_L(0); PG8_BAR; PG8_MMA(0, 0, At, B0); PG8_MMA(0, 1, At, B1); PG8_BAR; PG8_SCHED;
            PG8_LDA(At, 0, 1); PG8_STAGE(PG8_SB(0, 0), b2, voffB); PG8_STAGE(PG8_SB(0, 1), b2 + hstep, voffB); PG8_STAGE_A(PG8_SA(0, 0), last, 0, kt2);
            PG8_WAIT_V(8); PG8_WAIT_L(0); PG8_BAR; PG8_MMA(1, 0, At, B0); PG8_MMA(1, 1, At, B1); PG8_BAR; PG8_SCHED;
            PG8_LDB(B0, 1, 0); PG8_LDB(B1, 1, 1); PG8_SCHED; PG8_LDA(At, 1, 0); PG8_STAGE_A(PG8_SA(0, 1), last, 1, kt2);
            PG8_WAIT_V(8); PG8_WAIT_L(0); PG8_BAR; PG8_MMA(0, 0, At, B0); PG8_MMA(0, 1, At, B1); PG8_BAR; PG8_SCHED;
            PG8_LDA(At, 1, 1); PG8_STAGE(PG8_SB(1, 0), b3, voffB); PG8_STAGE(PG8_SB(1, 1), b3 + hstep, voffB); PG8_STAGE_A(PG8_SA(1, 0), last, 0, kt3);
            PG8_WAIT_V(8); PG8_WAIT_L(0); PG8_BAR; PG8_MMA(1, 0, At, B0); PG8_MMA(1, 1, At, B1); PG8_BAR; PG8_SCHED;
            } else {
            PG8_LDB(B0, 0, 0); PG8_SCHED; PG8_LDA(At, 0, 0); PG8_STAGE_A(PG8_SA(1, 1), false, 1, t + 1);
            PG8_WAIT_L(8); PG8_BAR; PG8_WAIT_L(0); PG8_MMA(0, 0, At, B0); PG8_BAR; PG8_SCHED;
            PG8_LDB(B1, 0, 1); PG8_STAGE(PG8_SB(0, 0), b2, voffB);
            PG8_BAR; PG8_WAIT_L(0); PG8_MMA(0, 1, At, B1); PG8_BAR;
            PG8_LDA(At, 0, 1); PG8_STAGE_A(PG8_SA(0, 0), last, 0, kt2);
            PG8_BAR; PG8_WAIT_L(0); PG8_MMA(1, 0, At, B0); PG8_BAR; PG8_SCHED;
            PG8_STAGE(PG8_SB(0, 1), b2 + hstep, voffB);
            PG8_WAIT_V(6); PG8_BAR; PG8_MMA(1, 1, At, B1); PG8_BAR;
            PG8_LDB(B0, 1, 0); PG8_SCHED; PG8_LDA(At, 1, 0); PG8_STAGE_A(PG8_SA(0, 1), last, 1, kt2);
            PG8_WAIT_L(8); PG8_BAR; PG8_WAIT_L(0); PG8_MMA(0, 0, At, B0); PG8_BAR; PG8_SCHED;
            PG8_LDB(B1, 1, 1); PG8_STAGE(PG8_SB(1, 0), b3, voffB);
            PG8_BAR; PG8_WAIT_L(0); PG8_MMA(0, 1, At, B1); PG8_BAR;
            PG8_LDA(At, 1, 1); PG8_STAGE_A(PG8_SA(1, 0), last, 0, kt3);
            PG8_BAR; PG8_WAIT_L(0); PG8_MMA(1, 0, At, B0); PG8_BAR; PG8_SCHED;
            PG8_STAGE(PG8_SB(1, 1), b3 + hstep, voffB);
            PG8_WAIT_V(6); PG8_BAR; PG8_MMA(1, 1, At, B1); PG8_BAR;
            }
        }
        if (wr == 0) PG8_BAR;
        if constexpr (FP8) {
#pragma unroll
            for (int a = 0; a < 2; ++a)
#pragma unroll
                for (int b = 0; b < 2; ++b) asm volatile("s_nop 15\n\ts_nop 15" : "+v"(acc[a][b][0][0]), "+v"(acc[a][b][0][1]), "+v"(acc[a][b][1][0]), "+v"(acc[a][b][1][1]), "+v"(acc[a][b][2][0]), "+v"(acc[a][b][2][1]), "+v"(acc[a][b][3][0]), "+v"(acc[a][b][3][1]));
        }
        const bool keep = E(acc, cur, wr, wc, fr, fq);
        if (!has_next) break;
        if (!keep) {
#pragma unroll
        for (int a = 0; a < 2; ++a)
#pragma unroll
            for (int b = 0; b < 2; ++b)
#pragma unroll
                for (int m = 0; m < 4; ++m)
#pragma unroll
                    for (int n = 0; n < 2; ++n) acc[a][b][m][n] = (f32x4){0.f, 0.f, 0.f, 0.f};
        }
        cur = nxt; cA = nA; cB = nB; ++ui;
        if constexpr (Sched::GATHER) { _Pragma("unroll") for (int _h = 0; _h < 2; ++_h) _Pragma("unroll") for (int _i = 0; _i < 2; ++_i) gofs[_h][_i] = ngofs[_h][_i]; }
        if (wr == 1) PG8_BAR;
    }
    PG8_WAIT_V(0);
    PG8_BAR;
#undef PG8_SA
#undef PG8_SB
#undef PG8_STAGE
#undef PG8_STAGE_A
#undef PG8_LDA
#undef PG8_LDB
#undef PG8_MMA
#undef PG8_WAIT_V
#undef PG8_WAIT_L
#undef PG8_BAR
#undef PG8_SCHED
#undef PG8_GOFS
}
}

namespace att {
constexpr int D = 128, NW = 8, QBLK = 32, KVBLK = 64, QB = NW * QBLK;
constexpr int SHM_V = KVBLK * D * 2, SHM_K = KVBLK * D * 2;
constexpr int ATT_WS_OFF = 2 * SHM_V + 2 * SHM_K;
constexpr int ATT_BIAS_OFF = ATT_WS_OFF + NW * 64 * 4;
constexpr int ATT_LDS_BYTES = ATT_BIAS_OFF + 4 * 128 * 4;
constexpr float SCALE = 0.08838834764831845f;
constexpr float THR = 8.f;
constexpr int WBIG = 1 << 30;

#define KSWZ(row, colB) ((row) * 256 + ((colB) ^ (((row) & 7) << 4)))
#define SBAR() __builtin_amdgcn_sched_barrier(0)
__device__ __forceinline__ int v_st(int k, int c) { const int kk = (k & ~0xC) | ((k & 4) << 1) | ((k & 8) >> 1); return ((kk >> 3) * 4 + (c >> 5)) * 512 + ((kk & 7) * 32 + (c & 31)) * 2; }
__device__ __forceinline__ int v_rd_base(int lane) { return ((lane & 3) << 3) | (((lane >> 2) & 3) << 6) | (((lane >> 4) & 1) << 5) | (((lane >> 5) & 1) << 8); }
constexpr int v_rd_off(int d0, int ks, int half) { return d0 * 512 + ks * 4096 + half * 2048; }
__device__ __forceinline__ int crow(int r, int hi) { return (r & 3) + 8 * (r >> 2) + 4 * hi; }
__device__ __forceinline__ unsigned cvtpk(float lo, float hi) { unsigned r; asm volatile("v_cvt_pk_bf16_f32 %0, %1, %2" : "=v"(r) : "v"(lo), "v"(hi)); return r; }
__device__ __forceinline__ bf16x8 load8(const bf16_t* p) { return *reinterpret_cast<const bf16x8*>(p); }

template <bool BIAS>
__device__ __forceinline__ void mask_tile(f32x16& p0, f32x16& p1, int dq, unsigned W, const float* btab) {
    const float NEG = -__builtin_inff();
#pragma unroll
    for (int r = 0; r < 16; ++r) {
        const int c = (r & 3) + 8 * (r >> 2);
        const unsigned d0 = (unsigned)(dq - c), d1 = (unsigned)(dq - c - 32);
        if (d0 >= W) p0[r] = NEG;
        if (d1 >= W) p1[r] = NEG;
    }
}
__device__ __forceinline__ void partialSM(f32x16& p0, f32x16& p1, float& m_reg, float& mn, float& alpha) {
    float pmax = p0[0]; for (int r = 1; r < 16; ++r) pmax = fmaxf(pmax, p0[r]); for (int r = 0; r < 16; ++r) pmax = fmaxf(pmax, p1[r]);
    { auto rr = __builtin_amdgcn_permlane32_swap(__float_as_uint(pmax), __float_as_uint(pmax), false, false);
      pmax = fmaxf(__uint_as_float(rr[0]), __uint_as_float(rr[1])); }
    constexpr float C2 = 1.4426950408889634f * SCALE;
    if (__builtin_expect(__all((pmax - m_reg) * SCALE <= THR), 1)) { mn = m_reg; alpha = 1.f; }
    else { mn = fmaxf(m_reg, pmax); alpha = __builtin_amdgcn_exp2f((m_reg - mn) * C2); m_reg = mn; }
    const float mnL = -mn * C2;
    for (int r = 0; r < 16; ++r) p0[r] = fmaf(p0[r], C2, mnL); for (int r = 0; r < 16; ++r) p1[r] = fmaf(p1[r], C2, mnL);
    for (int r = 0; r < 16; ++r) p0[r] = __builtin_amdgcn_exp2f(p0[r]);
}
__device__ __forceinline__ void finishSM(f32x16& p0, f32x16& p1, float alpha, float& l_reg, bf16x8& pa0, bf16x8& pa1, bf16x8& pa2, bf16x8& pa3) {
    for (int r = 0; r < 16; ++r) p1[r] = __builtin_amdgcn_exp2f(p1[r]);
    float ps = 0; for (int r = 0; r < 16; ++r) ps += p0[r]; for (int r = 0; r < 16; ++r) ps += p1[r];
    { auto rr = __builtin_amdgcn_permlane32_swap(__float_as_uint(ps), __float_as_uint(ps), false, false);
      ps = __uint_as_float(rr[0]) + __uint_as_float(rr[1]); }
    l_reg = l_reg * alpha + ps;
#define PK4(P, B_, OUT) do { unsigned a0 = cvtpk(P[B_+0], P[B_+1]), a1 = cvtpk(P[B_+2], P[B_+3]);                          \
        unsigned b0 = cvtpk(P[B_+4], P[B_+5]), b1 = cvtpk(P[B_+6], P[B_+7]);                                             \
        auto r0 = __builtin_amdgcn_permlane32_swap(a0, b0, false, false); auto r1 = __builtin_amdgcn_permlane32_swap(a1, b1, false, false); \
        u32x4 w = {r0[0], r1[0], r0[1], r1[1]}; OUT = *reinterpret_cast<bf16x8*>(&w); } while (0)
    PK4(p0, 0, pa0); PK4(p0, 8, pa1); PK4(p1, 0, pa2); PK4(p1, 8, pa3);
#undef PK4
}
template <int KB, bool BIAS>
__device__ __forceinline__ void qkt(f32x16& p0, f32x16& p1, const char* K_lds, int r32, int hi, const bf16x8* qr, bool need, int dq, const float* btab) {
    p0 = f32x16{}; p1 = f32x16{};
    if (BIAS && need) {
#pragma unroll
        for (int r = 0; r < 16; ++r) { const int c = (r & 3) + 8 * (r >> 2); const unsigned d0 = (unsigned)(dq - c), d1 = (unsigned)(dq - c - 32);
            p0[r] = btab[d0 < 127u ? d0 : 127u]; p1[r] = btab[d1 < 127u ? d1 : 127u]; }
    }
    const char* kb[4];
#pragma unroll
    for (int dd = 0; dd < 4; ++dd) kb[dd] = K_lds + KB * SHM_K + KSWZ(r32, (dd * 16 + hi * 8) * 2);
#pragma unroll
    for (int d0 = 0; d0 < 8; ++d0) { const char* a = kb[d0 & 3] + (d0 >> 2) * 128;
        bf16x8 b0 = *reinterpret_cast<const bf16x8*>(a);
        bf16x8 b1 = *reinterpret_cast<const bf16x8*>(a + 32 * 256);
        p0 = __builtin_amdgcn_mfma_f32_32x32x16_bf16(b0, qr[d0], p0, 0, 0, 0);
        p1 = __builtin_amdgcn_mfma_f32_32x32x16_bf16(b1, qr[d0], p1, 0, 0, 0); }
}
template <int VB>
__device__ __forceinline__ void pv_tile(f32x16* o, int vb0, bf16x8 pa0, bf16x8 pa1, bf16x8 pa2, bf16x8 pa3) {
#define TRRD(dst, off) asm volatile("ds_read_b64_tr_b16 %0, %1 offset:%2" : "=&v"(dst) : "v"(vb0), "i"(off) : "memory")
#define PV_D0(d0) do { s16x4 l0, l1, l2, l3, h0, h1, h2, h3; constexpr int b_ = VB * SHM_V + v_rd_off(d0, 0, 0); \
        TRRD(l0, b_); TRRD(h0, b_ + 2048); TRRD(l1, b_ + 4096); TRRD(h1, b_ + 6144); TRRD(l2, b_ + 8192); TRRD(h2, b_ + 10240); TRRD(l3, b_ + 12288); TRRD(h3, b_ + 14336); \
        asm volatile("s_waitcnt lgkmcnt(0)" ::: "memory"); SBAR();   \
        o[d0] = __builtin_amdgcn_mfma_f32_32x32x16_bf16(pa0, (bf16x8){l0[0], l0[1], l0[2], l0[3], h0[0], h0[1], h0[2], h0[3]}, o[d0], 0, 0, 0);   \
        o[d0] = __builtin_amdgcn_mfma_f32_32x32x16_bf16(pa1, (bf16x8){l1[0], l1[1], l1[2], l1[3], h1[0], h1[1], h1[2], h1[3]}, o[d0], 0, 0, 0);   \
        o[d0] = __builtin_amdgcn_mfma_f32_32x32x16_bf16(pa2, (bf16x8){l2[0], l2[1], l2[2], l2[3], h2[0], h2[1], h2[2], h2[3]}, o[d0], 0, 0, 0);   \
        o[d0] = __builtin_amdgcn_mfma_f32_32x32x16_bf16(pa3, (bf16x8){l3[0], l3[1], l3[2], l3[3], h3[0], h3[1], h3[2], h3[3]}, o[d0], 0, 0, 0); } while (0)
    PV_D0(0); PV_D0(1); PV_D0(2); PV_D0(3);
#undef PV_D0
#undef TRRD
}

struct BlockRef { const bf16_t* Q; const bf16_t* K; const bf16_t* V; bf16_t* O; int P0; const float* btab; };
struct Seam { bf16x8 qr[8]; bf16x8 st_v0, st_v1, st_k0, st_k1; };
template <int PQ_, int PKV_, int PO_> struct Pitch { static constexpr int q = PQ_, kv = PKV_, o = PO_; };
__device__ __forceinline__ int swa_jlo(int P0, int W) { const int lowk = P0 - W + 1; return lowk > 0 ? lowk / KVBLK : 0; }
#define ROWP(p, k0, rr) ((p) + (size_t)((k0) + (rr)) * PT.kv + sc)
#define VMW() asm volatile("s_waitcnt vmcnt(0)" ::: "memory")
#define VMWN(n) asm volatile("s_waitcnt vmcnt(%0)" :: "i"(n) : "memory")
#define SLOAD_H(Kp, Vp, k0) do { S.st_v0 = load8(ROWP(Vp, k0, sr)); S.st_v1 = load8(ROWP(Vp, k0, 32 + sr));              \
                         S.st_k0 = load8(ROWP(Kp, k0, sr)); S.st_k1 = load8(ROWP(Kp, k0, 32 + sr)); } while (0)
#define SWRITE_HK(bf) do { *(bf16x8*)(K_lds + (bf) * SHM_K + kws) = S.st_k0; *(bf16x8*)(K_lds + (bf) * SHM_K + kws + 32 * 256) = S.st_k1; } while (0)
#define SWRITE_HV(bf) do { *(bf16x8*)(V_lds + (bf) * SHM_V + vst0) = S.st_v0; *(bf16x8*)(V_lds + (bf) * SHM_V + vst1) = S.st_v1; } while (0)
#define SWRITE_H(bf) do { SWRITE_HV(bf); SWRITE_HK(bf); } while (0)
template <class PTt>
__device__ __forceinline__ void attn_prime(const BlockRef& cur, int W, char* lds, Seam& S, const int wid) {
    constexpr PTt PT{};
    const int lane = lane_id_opaque(), tid = (wid << 6) | lane, r32 = lane & 31, hi = lane >> 5;
    const int sr = tid >> 4, sc = (tid & 15) * 8, kws = KSWZ(sr, sc * 2); char* K_lds = lds + 2 * SHM_V;
    const int kb0 = swa_jlo(cur.P0, W) * KVBLK;
    for (int d0 = 0; d0 < 8; ++d0) S.qr[d0] = load8(cur.Q + (size_t)(wid * QBLK + r32) * PT.q + d0 * 16 + hi * 8);
    SLOAD_H(cur.K, cur.V, kb0); VMW(); SWRITE_HK(0);
    __syncthreads();
}
template <bool BIAS, class PTt>
__device__ __forceinline__ void attn_block(const BlockRef& cur, const BlockRef& nxt, int skv, int W, char* lds, Seam& S, const int wid) {
    constexpr PTt PT{};
    const int lane = lane_id_opaque(), tid = (wid << 6) | lane, r32 = lane & 31, hi = lane >> 5;
    const int j_lo = swa_jlo(cur.P0, W);
    int j_hi = (cur.P0 + QB - 1) / KVBLK + 1; if (j_hi > skv / KVBLK) j_hi = skv / KVBLK;
    const int NT = j_hi - j_lo;
    const int kbn = swa_jlo(nxt.P0, W) * KVBLK;
    const int qlo = cur.P0 + wid * QBLK, qm = qlo + r32 - 4 * hi;
    char* V_lds = lds; char* K_lds = lds + 2 * SHM_V;
    float* ws = (float*)(lds + ATT_WS_OFF) + wid * 64; float* li_l = ws, * al_l = ws + 32;
    float m_reg = -1e30f, l_reg = 0; f32x16 o[4] = {};
    const int sr = tid >> 4, sc = (tid & 15) * 8, vst0 = v_st(sr, sc), vst1 = v_st(32 + sr, sc), kws = KSWZ(sr, sc * 2);
    const int vb0 = (int)(uintptr_t)V_lds + v_rd_base(lane);
    const bf16_t* Kh = cur.K; const bf16_t* Vh = cur.V; const float* btab = cur.btab;
#define RESC(a) do { if (__any((a) < 1.f)) { if (hi == 0) al_l[r32] = (a); asm volatile("s_waitcnt lgkmcnt(0)" ::: "memory");              \
                     for (int d_ = 0; d_ < 4; ++d_) for (int r = 0; r < 16; ++r) o[d_][r] *= al_l[crow(r, hi)]; } } while (0)
#define KBASE(t) ((j_lo + (t)) * KVBLK)
#define MASKT(P0_, P1_, t) do { const int kb_ = KBASE(t); if (kb_ + KVBLK - 1 > qlo || kb_ <= qlo + QBLK - 1 - W) mask_tile<BIAS>(P0_, P1_, qm - kb_, (unsigned)W, btab); } while (0)
#define NEEDB(t) (BIAS && KBASE(t) + KVBLK - 1 + 113 > qlo)
#define QKT(KB_, PX0, PX1, t) qkt<KB_, BIAS>(PX0, PX1, K_lds, r32, hi, S.qr, NEEDB(t), qm - KBASE(t), btab)
    constexpr int NQL = 8;
#define SEAM_K0() do { VMWN(NQL); SWRITE_HK(0); SBAR(); } while (0)
    f32x16 pA0, pA1, pB0, pB1; float mnA, mnB, alA, alB; bf16x8 pa0, pa1, pa2, pa3;
    SWRITE_HV(0); SBAR();
    if (NT > 1) { SLOAD_H(Kh, Vh, KBASE(1)); }
    SBAR(); QKT(0, pA0, pA1, 0);
    MASKT(pA0, pA1, 0); partialSM(pA0, pA1, m_reg, mnA, alA);
    if (NT > 1) { VMW(); SWRITE_H(1); }
    __syncthreads();
#define HALF_STEP(PX0, PX1, mnX, alX, PY0, PY1, alY, t, KB, VB, SB) do {                                                      \
        SBAR(); QKT(KB, PX0, PX1, (t));                                                                           \
        finishSM(PY0, PY1, alY, l_reg, pa0, pa1, pa2, pa3); SBAR();                                                           \
        if ((t) + 1 < NT) { SLOAD_H(Kh, Vh, KBASE((t) + 1)); SBAR(); }                                                        \
        pv_tile<VB>(o, vb0, pa0, pa1, pa2, pa3); MASKT(PX0, PX1, (t)); partialSM(PX0, PX1, m_reg, mnX, alX);                  \
        __syncthreads();                                                                                                      \
        if ((t) + 1 < NT) { VMW(); SWRITE_H(SB); }                                                                            \
        RESC(alX); __syncthreads(); } while (0)
    for (int t = 1; t + 1 < NT; t += 2) {
        HALF_STEP(pB0, pB1, mnB, alB, pA0, pA1, alA, t, 1, 0, 0);
        HALF_STEP(pA0, pA1, mnA, alA, pB0, pB1, alB, t + 1, 0, 1, 1);
    }
    const bool even = (NT & 1) == 0;
    if (even) { SBAR(); QKT(1, pB0, pB1, NT - 1); SBAR(); }
    SLOAD_H(nxt.K, nxt.V, kbn); SBAR();
#pragma unroll
    for (int d0 = 0; d0 < 8; ++d0) S.qr[d0] = load8(nxt.Q + (size_t)(wid * QBLK + r32) * PT.q + d0 * 16 + hi * 8);
    SBAR();
    finishSM(pA0, pA1, alA, l_reg, pa0, pa1, pa2, pa3); SBAR();
    pv_tile<0>(o, vb0, pa0, pa1, pa2, pa3);
    if (even) { MASKT(pB0, pB1, NT - 1); partialSM(pB0, pB1, m_reg, mnB, alB); __syncthreads(); RESC(alB);
        finishSM(pB0, pB1, alB, l_reg, pa0, pa1, pa2, pa3); SBAR(); pv_tile<1>(o, vb0, pa0, pa1, pa2, pa3); }
    SBAR(); SEAM_K0();
    if (hi == 0) li_l[r32] = l_reg; asm volatile("s_waitcnt lgkmcnt(0)" ::: "memory");
    float rli[16];
#pragma unroll
    for (int r = 0; r < 16; ++r) rli[r] = __builtin_amdgcn_rcpf(li_l[crow(r, hi)]);
    bf16_t* Ow = cur.O + (size_t)(wid * QBLK) * PT.o;
#pragma unroll
    for (int r = 0; r < 16; ++r) { const int orow = crow(r, hi);
#pragma unroll
        for (int d0 = 0; d0 < 4; ++d0) { const float v = o[d0][r] * rli[r];
            const float vn = __int_as_float(__builtin_amdgcn_ds_swizzle(__float_as_int(v), 0x041F));
            if ((r32 & 1) == 0) *(unsigned*)(Ow + (size_t)orow * PT.o + d0 * 32 + r32) = cvtpk(v, vn); } }
    __syncthreads();
#undef RESC
#undef KBASE
#undef MASKT
#undef NEEDB
#undef QKT
#undef SEAM_K0
#undef HALF_STEP
}
#undef ROWP
#undef VMW
#undef VMWN
#undef SLOAD_H
#undef SWRITE_HK
#undef SWRITE_HV
#undef SWRITE_H
}

namespace att2 {
using att::crow; using att::cvtpk; using att::load8; using att::v_rd_base; using att::SCALE; using att::THR;
constexpr int D = 128, DV = 256, KVBLK = 64, QROWS = 128;
constexpr int SHM_K = KVBLK * D * 2, SHM_V = KVBLK * DV * 2;
constexpr int OFF_K = 0, OFF_V = 2 * SHM_K;
constexpr int OFF_XM = OFF_V + 2 * SHM_V;
constexpr int OFF_XS = OFF_XM + 1024;
constexpr int OFF_XPA = OFF_XS + 1024;
constexpr int OFF_WS = OFF_XPA + 16384;
constexpr int OFF_BIAS = OFF_WS + 2048;
constexpr int LDS_END = OFF_BIAS + 2048;
__device__ __forceinline__ int v_st2(int k, int c) { const int kk = (k & ~0xC) | ((k & 4) << 1) | ((k & 8) >> 1); return ((kk >> 3) * 8 + (c >> 5)) * 512 + ((kk & 7) * 32 + (c & 31)) * 2; }
struct Blk { const bf16_t* Q; const bf16_t* K; const bf16_t* V; bf16_t* O; int P0; const float* btab; };

__device__ __forceinline__ void attn_block(const Blk& B, char* lds, LAS unsigned char* ldsl, const int wid) {
    constexpr int LDQ = 256, LDKV = 256, LDO = 2048;
    const int lane = lane_id_opaque(), tid = (wid << 6) | lane, r32 = lane & 31, hi = lane >> 5, pr = wid >> 1, sh = wid & 1;
    char* K_lds = lds + OFF_K; char* V_lds = lds + OFF_V;
    float* xm = (float*)(lds + OFF_XM); float* xs = (float*)(lds + OFF_XS); char* xpa = lds + OFF_XPA;
    float* wsf = (float*)(lds + OFF_WS) + wid * 64; float* li_l = wsf; float* al_l = wsf + 32;
    const float* btab = B.btab;
    const int NT = (B.P0 + QROWS - 1) / KVBLK + 1;
    const int qlo = B.P0 + pr * 32, qm = qlo + r32 - 4 * hi;
    unsigned ksrc[2], vsrc[4];
#pragma unroll
    for (int i = 0; i < 2; ++i) { const int o = (wid * 2 + i) * 1024 + lane * 16; const int row = o >> 8, cs = (o >> 4) & 15; ksrc[i] = (unsigned)(row * (LDKV * 2) + ((cs ^ (row & 7)) << 4)); }
#pragma unroll
    for (int i = 0; i < 4; ++i) { const int o = (wid * 4 + i) * 1024 + lane * 16; const int st = o >> 9, r = (o >> 6) & 7, q = (o >> 4) & 3;
        const int kk = (st >> 3) * 8 + r, k = (kk & ~0xC) | ((kk & 4) << 1) | ((kk & 8) >> 1), c = (st & 7) * 32 + q * 8; vsrc[i] = (unsigned)(k * (LDKV * 2) + c * 2); }
    const int vb0 = (int)(uintptr_t)V_lds + v_rd_base(lane) + sh * 2048 + sh * 16384;
    const int vb1 = vb0 + 16384 - sh * 32768;
    bf16x8 qr[8];
    f32x16 o[4] = {}; float m_reg = -1e30f, l_reg = 0.f;
#define A2_DMA_K(bf, kb) do { const char* kp_ = (const char*)(B.K + (size_t)(kb) * LDKV); _Pragma("unroll") for (int i_ = 0; i_ < 2; ++i_) \
        __builtin_amdgcn_global_load_lds((const unsigned*)(kp_ + ksrc[i_]), (LAS unsigned*)(ldsl + OFF_K + (bf) * SHM_K + (wid * 2 + i_) * 1024), 16, 0, 0); } while (0)
#define A2_DMA_V(bf, kb) do { const char* vp_ = (const char*)(B.V + (size_t)(kb) * LDKV); _Pragma("unroll") for (int i_ = 0; i_ < 4; ++i_) \
        __builtin_amdgcn_global_load_lds((const unsigned*)(vp_ + vsrc[i_]), (LAS unsigned*)(ldsl + OFF_V + (bf) * SHM_V + (wid * 4 + i_) * 1024), 16, 0, 0); } while (0)
#define A2_VMW() asm volatile("s_waitcnt vmcnt(0)" ::: "memory")
#define A2_VMW2() asm volatile("s_waitcnt vmcnt(2)" ::: "memory")
#define A2_KB(t) ((t) * KVBLK)
#define A2_QK(KB_, P, t) do { const int kb_ = A2_KB(t); const int dqo_ = qm - kb_ - 32 * sh; \
        const char* kb4_[4]; _Pragma("unroll") for (int dd = 0; dd < 4; ++dd) kb4_[dd] = K_lds + (KB_) * SHM_K + KSWZ(32 * sh + r32, (dd * 16 + hi * 8) * 2); \
        if (kb_ + KVBLK - 1 + 113 > qlo) { _Pragma("unroll") for (int r = 0; r < 16; ++r) { const unsigned d_ = (unsigned)(dqo_ - ((r & 3) + 8 * (r >> 2))); P[r] = btab[d_ < 127u ? d_ : 127u]; } \
          _Pragma("unroll") for (int d0 = 0; d0 < 8; ++d0) { const bf16x8 kf_ = *reinterpret_cast<const bf16x8*>(kb4_[d0 & 3] + (d0 >> 2) * 128); \
              P = __builtin_amdgcn_mfma_f32_32x32x16_bf16(kf_, qr[d0], P, 0, 0, 0); } } \
        else {     \
          { const bf16x8 kf_ = *reinterpret_cast<const bf16x8*>(kb4_[0]); P = __builtin_amdgcn_mfma_f32_32x32x16_bf16(kf_, qr[0], f32x16{}, 0, 0, 0); } \
          _Pragma("unroll") for (int d0 = 1; d0 < 8; ++d0) { const bf16x8 kf_ = *reinterpret_cast<const bf16x8*>(kb4_[d0 & 3] + (d0 >> 2) * 128); \
              P = __builtin_amdgcn_mfma_f32_32x32x16_bf16(kf_, qr[d0], P, 0, 0, 0); } } } while (0)
#define A2_MX(P, t) do { const int kb_ = A2_KB(t); const int dqo_ = qm - kb_ - 32 * sh; \
        if (kb_ + KVBLK - 1 > qlo) { const float NEG_ = -__builtin_inff(); _Pragma("unroll") for (int r = 0; r < 16; ++r) { if ((unsigned)(dqo_ - ((r & 3) + 8 * (r >> 2))) >= 0x40000000u) P[r] = NEG_; } } \
        float pm_ = P[0]; _Pragma("unroll") for (int r = 1; r < 16; ++r) pm_ = fmaxf(pm_, P[r]); \
        { auto rr_ = __builtin_amdgcn_permlane32_swap(__float_as_uint(pm_), __float_as_uint(pm_), false, false); pm_ = fmaxf(__uint_as_float(rr_[0]), __uint_as_float(rr_[1])); } \
        pmloc = pm_; if (hi == 0) xm[wid * 32 + r32] = pm_; } while (0)
#define A2_SM1A(alX, DO) constexpr float C2 = 1.4426950408889634f * SCALE; float mnL_ = 0.f; \
        if (DO) { const float pmax_ = fmaxf(pmloc, xm[(wid ^ 1) * 32 + r32]); float mn_; \
            if (__builtin_expect(__all((pmax_ - m_reg) * SCALE <= THR), 1)) { mn_ = m_reg; alX = 1.f; } \
            else { mn_ = fmaxf(m_reg, pmax_); alX = __builtin_amdgcn_exp2f((m_reg - mn_) * C2); m_reg = mn_; } \
            mnL_ = -mn_ * C2; }
#define A2_SM1B(P, r0) do { _Pragma("unroll") for (int r = (r0); r < (r0) + 4; ++r) P[r] = __builtin_amdgcn_exp2f(fmaf(P[r], C2, mnL_)); } while (0)
#define A2_FIN(P) do { float ps_ = 0.f; _Pragma("unroll") for (int r = 0; r < 16; ++r) ps_ += P[r]; \
        { auto rr_ = __builtin_amdgcn_permlane32_swap(__float_as_uint(ps_), __float_as_uint(ps_), false, false); ps_ = __uint_as_float(rr_[0]) + __uint_as_float(rr_[1]); } \
        psown = ps_; if (hi == 0) xs[wid * 32 + r32] = ps_; \
        { unsigned a0_ = cvtpk(P[0], P[1]), a1_ = cvtpk(P[2], P[3]), b0_ = cvtpk(P[4], P[5]), b1_ = cvtpk(P[6], P[7]); \
          auto r0_ = __builtin_amdgcn_permlane32_swap(a0_, b0_, false, false); auto r1_ = __builtin_amdgcn_permlane32_swap(a1_, b1_, false, false); \
          u32x4 w_ = {r0_[0], r1_[0], r0_[1], r1_[1]}; paown0 = *reinterpret_cast<bf16x8*>(&w_); } \
        { unsigned a0_ = cvtpk(P[8], P[9]), a1_ = cvtpk(P[10], P[11]), b0_ = cvtpk(P[12], P[13]), b1_ = cvtpk(P[14], P[15]); \
          auto r0_ = __builtin_amdgcn_permlane32_swap(a0_, b0_, false, false); auto r1_ = __builtin_amdgcn_permlane32_swap(a1_, b1_, false, false); \
          u32x4 w_ = {r0_[0], r1_[0], r0_[1], r1_[1]}; paown1 = *reinterpret_cast<bf16x8*>(&w_); } \
        *(bf16x8*)(xpa + (wid * 2 + 0) * 1024 + lane * 16) = paown0; *(bf16x8*)(xpa + (wid * 2 + 1) * 1024 + lane * 16) = paown1; } while (0)
#define A2_TR(dst, vb, off) asm volatile("ds_read_b64_tr_b16 %0, %1 offset:%2" : "=&v"(dst) : "v"(vb), "i"(off) : "memory")
#define A2_TRL(VB_, d0, T) do { constexpr int b_ = (VB_) * SHM_V + (d0) * 512; \
        A2_TR(T##l0, vb0, b_); A2_TR(T##h0, vb0, b_ + 4096); A2_TR(T##l1, vb0, b_ + 8192); A2_TR(T##h1, vb0, b_ + 12288); A2_TR(T##l2, vb1, b_); A2_TR(T##h2, vb1, b_ + 4096); A2_TR(T##l3, vb1, b_ + 8192); A2_TR(T##h3, vb1, b_ + 12288); } while (0)
#define A2_MM(d0, T) do { \
        o[d0] = __builtin_amdgcn_mfma_f32_32x32x16_bf16(pa0_, (bf16x8){T##l0[0], T##l0[1], T##l0[2], T##l0[3], T##h0[0], T##h0[1], T##h0[2], T##h0[3]}, o[d0], 0, 0, 0); \
        o[d0] = __builtin_amdgcn_mfma_f32_32x32x16_bf16(pa1_, (bf16x8){T##l1[0], T##l1[1], T##l1[2], T##l1[3], T##h1[0], T##h1[1], T##h1[2], T##h1[3]}, o[d0], 0, 0, 0); \
        o[d0] = __builtin_amdgcn_mfma_f32_32x32x16_bf16(pa2_, (bf16x8){T##l2[0], T##l2[1], T##l2[2], T##l2[3], T##h2[0], T##h2[1], T##h2[2], T##h2[3]}, o[d0], 0, 0, 0); \
        o[d0] = __builtin_amdgcn_mfma_f32_32x32x16_bf16(pa3_, (bf16x8){T##l3[0], T##l3[1], T##l3[2], T##l3[3], T##h3[0], T##h3[1], T##h3[2], T##h3[3]}, o[d0], 0, 0, 0); } while (0)
#define A2_LW() do { asm volatile("s_waitcnt lgkmcnt(0)" ::: "memory"); __builtin_amdgcn_sched_barrier(0); } while (0)
#define A2_PV(VB_, alY, WITH_SM, PX, alX, PRE) do { \
        const bf16x8 pp0_ = *(const bf16x8*)(xpa + ((wid ^ 1) * 2 + 0) * 1024 + lane * 16), pp1_ = *(const bf16x8*)(xpa + ((wid ^ 1) * 2 + 1) * 1024 + lane * 16); \
        const float pso_ = xs[(wid ^ 1) * 32 + r32]; \
        A2_SM1A(alX, WITH_SM); \
        if (!(PRE)) A2_TRL(VB_, 0, X); \
        l_reg = l_reg * alY + (psown + pso_); \
        const bf16x8 pa0_ = paown0, pa1_ = paown1, pa2_ = pp0_, pa3_ = pp1_; \
        A2_LW(); \
        A2_TRL(VB_, 1, Y); A2_MM(0, X); if (WITH_SM) A2_SM1B(PX, 0); A2_LW(); \
        A2_TRL(VB_, 2, X); A2_MM(1, Y); if (WITH_SM) A2_SM1B(PX, 4); A2_LW(); \
        A2_TRL(VB_, 3, Y); A2_MM(2, X); if (WITH_SM) A2_SM1B(PX, 8); A2_LW(); \
        A2_MM(3, Y); if (WITH_SM) A2_SM1B(PX, 12); } while (0)
#define A2_RESC(a) do { if (__any((a) < 1.f)) { if (hi == 0) al_l[r32] = (a); asm volatile("s_waitcnt lgkmcnt(0)" ::: "memory"); \
        _Pragma("unroll") for (int d_ = 0; d_ < 4; ++d_) _Pragma("unroll") for (int r = 0; r < 16; ++r) o[d_][r] *= al_l[crow(r, hi)]; } } while (0)
    f32x16 PA, PB; float alA = 1.f, alB = 1.f, pmloc = 0.f, psown = 0.f; bf16x8 paown0, paown1;
    s16x4 Xl0, Xl1, Xl2, Xl3, Xh0, Xh1, Xh2, Xh3, Yl0, Yl1, Yl2, Yl3, Yh0, Yh1, Yh2, Yh3;
#pragma unroll
    for (int d0 = 0; d0 < 8; ++d0) qr[d0] = load8(B.Q + (size_t)(pr * 32 + r32) * LDQ + d0 * 16 + hi * 8);
    A2_DMA_K(0, 0); A2_DMA_V(0, 0); A2_VMW();
    __syncthreads();
    A2_DMA_K(1, A2_KB(1));
    A2_QK(0, PA, 0); A2_MX(PA, 0);
    __syncthreads();
    if (NT > 2) A2_DMA_K(0, A2_KB(2));
    { A2_SM1A(alA, true); A2_SM1B(PA, 0); A2_SM1B(PA, 4); A2_SM1B(PA, 8); A2_SM1B(PA, 12); }
    if (NT > 2) A2_VMW2(); else A2_VMW();
    __syncthreads();
    A2_DMA_V(1, A2_KB(1));
#define A2_STEP(PX, alX, PY, alY, t, KBX, VBY, more) do { \
        __builtin_amdgcn_sched_barrier(0); A2_QK(KBX, PX, t); A2_FIN(PY); A2_MX(PX, t); \
        A2_TRL(VBY, 0, X);     \
        __syncthreads(); \
        if ((t) + 2 < NT) A2_DMA_K(KBX, A2_KB((t) + 2));     \
        A2_PV(VBY, alY, true, PX, alX, true); \
        if ((t) + 2 < NT) A2_VMW2(); else A2_VMW(); \
        A2_RESC(alX); \
        __syncthreads(); \
        if (more) A2_DMA_V(VBY, A2_KB((t) + 1)); } while (0)
    for (int t = 1; t + 1 < NT; t += 2) {
        A2_STEP(PB, alB, PA, alA, t, 1, 0, true);
        A2_STEP(PA, alA, PB, alB, t + 1, 0, 1, true);
    }
    A2_STEP(PB, alB, PA, alA, NT - 1, 1, 0, false);
    A2_FIN(PB);
    __syncthreads();
    { float aldummy = 1.f; A2_PV(1, alB, false, PB, aldummy, false); (void)aldummy; }
    if (hi == 0) li_l[r32] = l_reg; asm volatile("s_waitcnt lgkmcnt(0)" ::: "memory");
    float rli[16];
#pragma unroll
    for (int r = 0; r < 16; ++r) rli[r] = __builtin_amdgcn_rcpf(li_l[crow(r, hi)]);
    bf16_t* Ow = B.O + (size_t)(pr * 32) * LDO + sh * 128;
#pragma unroll
    for (int r = 0; r < 16; ++r) { const int orow = crow(r, hi);
#pragma unroll
        for (int d0 = 0; d0 < 4; ++d0) { const float v = o[d0][r] * rli[r];
            const float vn = __int_as_float(__builtin_amdgcn_ds_swizzle(__float_as_int(v), 0x041F));
            if ((r32 & 1) == 0) *(unsigned*)(Ow + (size_t)orow * LDO + d0 * 32 + r32) = cvtpk(v, vn); } }
    __syncthreads();
#undef A2_DMA_K
#undef A2_DMA_V
#undef A2_VMW
#undef A2_VMW2
#undef A2_KB
#undef A2_QK
#undef A2_MX
#undef A2_SM1A
#undef A2_SM1B
#undef A2_TRL
#undef A2_MM
#undef A2_LW
#undef A2_FIN
#undef A2_PV
#undef A2_TR
#undef A2_RESC
#undef A2_STEP
}
}

#define XB_TMO      128
#define XB_XCNT(j)  (256  + 64 * (j))
#define XB_XSUB(j)  (1280 + 64 * (j))
#define XB_XGEN(j)  (2304 + 64 * (j))
#define XB_TOP      3328
#define XB_TOPGEN   3392
#define XCD_BAR_WORDS 3456
#define XB_SPIN_CAP (1u << 18)
__device__ __forceinline__ unsigned xb_ld(unsigned* p)              { return __hip_atomic_load(p, __ATOMIC_RELAXED, __HIP_MEMORY_SCOPE_AGENT); }
__device__ __forceinline__ unsigned xb_add(unsigned* p, unsigned v) { return __hip_atomic_fetch_add(p, v, __ATOMIC_RELAXED, __HIP_MEMORY_SCOPE_AGENT); }
__device__ __forceinline__ unsigned xb_xcc_id() { return (unsigned)__builtin_amdgcn_s_getreg((3 << 11) | 20) & 0xFu; }
#define XB_SPIN(cond, bar) do { unsigned _sp = 0; while (cond) { __builtin_amdgcn_s_sleep(1); \
    if ((++_sp & 255u) == 0u) { if (xb_ld(&(bar)[XB_TMO])) break; if (_sp > XB_SPIN_CAP) { atomicAdd(&(bar)[XB_TMO], 1u); break; } } } } while (0)
struct XcdBarrier { unsigned* bar; unsigned x; volatile LAS unsigned* st; int wv; };
__device__ __forceinline__ XcdBarrier xcd_barrier_post(unsigned* bar, volatile LAS unsigned* st) {
    XcdBarrier b; b.bar = bar; b.x = xb_xcc_id(); b.st = st; b.wv = 0;
    if (threadIdx.x == 0) (void)xb_add(&bar[XB_XCNT(b.x)], 1u);
    return b;
}
__device__ __forceinline__ void xcd_barrier_complete(unsigned* bar, unsigned x, unsigned& nloc, unsigned& nx) {
    const unsigned G = gridDim.x * gridDim.y * gridDim.z;
    unsigned sum, cnt, mine, sp = 0u;
    for (;;) {
        sum = 0u; cnt = 0u; mine = 0u;
#pragma unroll
        for (unsigned j = 0; j < 16; ++j) { const unsigned c = xb_ld(&bar[XB_XCNT(j)]); sum += c; cnt += (c > 0u) ? 1u : 0u; mine = (j == x) ? c : mine; }
        if (sum == G) break;
        __builtin_amdgcn_s_sleep(1);
        if ((++sp & 255u) == 0u) { if (xb_ld(&bar[XB_TMO])) break; if (sp > XB_SPIN_CAP) { atomicAdd(&bar[XB_TMO], 1u); break; } }
    }
    nloc = mine > 0u ? mine : 1u; nx = cnt > 0u ? cnt : 1u;
}
__device__ __forceinline__ void xcd_barrier(const XcdBarrier& b) {
    asm volatile("s_waitcnt vmcnt(0)" ::: "memory");
    __syncthreads();
    if (b.wv == 0 && lane_id_opaque() == 0) {
        unsigned* bar = b.bar;
        __builtin_amdgcn_s_waitcnt(0);
        unsigned nloc = b.st[0], nx = b.st[1];
        if (nloc == 0u) { xcd_barrier_complete(bar, b.x, nloc, nx); b.st[0] = nloc; b.st[1] = nx; }
        const unsigned old = xb_add(&bar[XB_XSUB(b.x)], 1u);
        const unsigned gen = old / nloc;
        if (old + 1u == (gen + 1u) * nloc) {
            __builtin_amdgcn_fence(__ATOMIC_RELEASE, "agent");
            asm volatile("s_waitcnt vmcnt(0)" ::: "memory");
            const unsigned og = xb_add(&bar[XB_TOP], 1u);
            const unsigned tg = og / nx;
            if (og + 1u == (tg + 1u) * nx) xb_add(&bar[XB_TOPGEN], 1u);
            else XB_SPIN(xb_ld(&bar[XB_TOPGEN]) == tg, bar);
            __builtin_amdgcn_fence(__ATOMIC_ACQUIRE, "agent");
            xb_add(&bar[XB_XGEN(b.x)], 1u);
            asm volatile("s_waitcnt vmcnt(0)" ::: "memory");
        } else {
            XB_SPIN(xb_ld(&bar[XB_XGEN(b.x)]) == gen, bar);
            __builtin_amdgcn_fence(__ATOMIC_ACQUIRE, "agent");
            asm volatile("s_waitcnt vmcnt(0)" ::: "memory");
        }
    }
    __syncthreads();
}

struct Params {
    const float* x; const float* mem; const float* t5; const float* w_in; const float* w_conv; const float* dlam; const float* dsub;
    const float* w_branch; const float* w_mix; const float* w_xq; const float* w_xkv; const float* w_xo;
    const float* w_fg; const float* w_fu; const float* w_fd; const float* w_router; const float* w_eg; const float* w_eu; const float* w_ed;
    const float* g_pre_mix; const float* g_post_mix; const float* g_pre_x; const float* g_mem; const float* g_post_x; const float* g_pre_ffn; const float* g_post_ffn;
    float* out; unsigned char* ws; int ph_lo, ph_hi;
};
struct Ctx { int G, c, wv, dry; LAS unsigned char* lds; unsigned char* ws; };
#define TID_INIT() const int lane = lane_id_opaque(); const int wave = X.wv; const int tid = (wave << 6) | lane; const int gw = X.c * 8 + wave; const int NGW = X.G * 8; (void)lane; (void)wave; (void)gw; (void)NGW

#ifndef FFN_GU_FP8
#define FFN_GU_FP8 0
#endif
#ifndef PROBE_CVT
#define PROBE_CVT 0
#endif
#define CVT_DECODE(it_, Wv, Nv, k0v, n0v, drowv, scv) do { \
        if (GU) { constexpr int nrb = 14336 / 64; const int kb_ = (it_) / nrb, rb_ = (it_) % nrb; const int r0_ = rb_ * 64, pn_ = r0_ >> 8, j0_ = r0_ & 255; \
            Wv = (j0_ < 128) ? W : W2; Nv = DFF; k0v = kb_ * 256; n0v = pn_ * 128 + (j0_ & 127); drowv = r0_; scv = scale; } \
        else { const int nnb_ = Nsrc / 64; const int kb_ = (it_) / nnb_, nb_ = (it_) % nnb_; Wv = W; Nv = Npitch; k0v = kb_ * 256; n0v = nb_ * 64; drowv = drow0 + nb_ * 64; scv = scale * ((nb_ * 64 < scols) ? cscale : 1.0f); } } while (0)
template <bool FP8, bool GU>
__device__ __forceinline__ void cvt_run(const Ctx& X, const float* W, const float* W2, int K, int Nsrc, int Npitch, unsigned char* dst, size_t dpitch_bytes, int drow0, int dcol0_bytes, const float* gain, int scols, float cscale, float scale, int rot) {
    TID_INIT();
    LAS float* scr = (LAS float*)X.lds;
    const int items = GU ? (DM / 256) * (14336 / 64) : (K / 256) * (Nsrc / 64);
    const int nl = (lane & 15) * 4, kr = lane >> 4;
    f32x4 v[8]; const float* Wc; int Nc, k0 = 0, n0, drow = 0; float sc = 1.f;
    int it = (X.c + rot) % X.G;
    if (it < items) { CVT_DECODE(it, Wc, Nc, k0, n0, drow, sc);
#pragma unroll
        for (int i = 0; i < 8; ++i) v[i] = __builtin_nontemporal_load((const f32x4*)(Wc + (size_t)(k0 + 32 * wave + 4 * i + kr) * Nc + n0 + nl)); }
    for (; it < items; it += X.G) {
#pragma unroll
        for (int i = 0; i < 8; ++i) { const int k = 32 * wave + 4 * i + kr; LAS float* s = scr + k * 65; const int rotn = nl + (k >> 3);
            s[(rotn + 0) & 63] = v[i][0]; s[(rotn + 1) & 63] = v[i][1]; s[(rotn + 2) & 63] = v[i][2]; s[(rotn + 3) & 63] = v[i][3]; }
        const int k0c = k0, drowc = drow; const float scc = sc;
        __syncthreads();
        if (it + X.G < items) { CVT_DECODE(it + X.G, Wc, Nc, k0, n0, drow, sc);
#pragma unroll
            for (int i = 0; i < 8; ++i) v[i] = __builtin_nontemporal_load((const f32x4*)(Wc + (size_t)(k0 + 32 * wave + 4 * i + kr) * Nc + n0 + nl)); }
        if (!(PROBE_CVT && X.dry == 1)) {
        if (FP8) { const int c = tid & 15, rr = tid >> 4;
            f32x4 g[4];
#pragma unroll
            for (int q = 0; q < 4; ++q) { g[q] = gain ? *(const f32x4*)(gain + k0c + 16 * c + 4 * q) : (f32x4){1.f, 1.f, 1.f, 1.f}; g[q] = g[q] * scc; }
#pragma unroll
            for (int ps = 0; ps < 2; ++ps) { const int n = 32 * ps + rr; float e[16];
#pragma unroll
                for (int j = 0; j < 16; ++j) { const int k = 16 * c + j; e[j] = scr[k * 65 + ((n + (k >> 3)) & 63)] * g[j >> 2][j & 3]; }
                u32x4 o; o.x = pk4_fp8(e[0], e[1], e[2], e[3]); o.y = pk4_fp8(e[4], e[5], e[6], e[7]); o.z = pk4_fp8(e[8], e[9], e[10], e[11]); o.w = pk4_fp8(e[12], e[13], e[14], e[15]);
                if (PROBE_CVT && X.dry == 2) asm volatile("" :: "v"(o)); else __builtin_nontemporal_store(o, (u32x4*)(dst + (size_t)(drowc + n) * dpitch_bytes + dcol0_bytes + k0c + 16 * c)); }
        } else { const int c = tid & 31, rr = tid >> 5;
            f32x4 g[2];
#pragma unroll
            for (int q = 0; q < 2; ++q) { g[q] = gain ? *(const f32x4*)(gain + k0c + 8 * c + 4 * q) : (f32x4){1.f, 1.f, 1.f, 1.f}; g[q] = g[q] * scc; }
#pragma unroll
            for (int ps = 0; ps < 4; ++ps) { const int n = 16 * ps + rr; float e[8];
#pragma unroll
                for (int j = 0; j < 8; ++j) { const int k = 8 * c + j; e[j] = scr[k * 65 + ((n + c) & 63)] * g[j >> 2][j & 3]; }
                u32x4 o; o.x = pk2(e[0], e[1]); o.y = pk2(e[2], e[3]); o.z = pk2(e[4], e[5]); o.w = pk2(e[6], e[7]);
                if (PROBE_CVT && X.dry == 2) asm volatile("" :: "v"(o)); else __builtin_nontemporal_store(o, (u32x4*)(dst + (size_t)(drowc + n) * dpitch_bytes + dcol0_bytes + (k0c + 8 * c) * 2)); }
        }
        }
        __syncthreads();
    }
}
__device__ __forceinline__ void cvt_matrix(const Ctx& X, const float* W, int K, int N, bf16_t* dst, size_t dpitch, int drow0, int dcol0, const float* gain, int scols, float cscale, int rot) {
    cvt_run<false, false>(X, W, nullptr, K, N, N, (unsigned char*)dst, dpitch * 2, drow0, dcol0 * 2, gain, scols, cscale, 1.0f, rot);
}
__device__ __forceinline__ void cvt_gateup(const Ctx& X, const float* Wg, const float* Wu, bf16_t* dst, const float* gain, int rot) {
    cvt_run<false, true>(X, Wg, Wu, DM, DFF, DFF, (unsigned char*)dst, (size_t)DM * 2, 0, 0, gain, 0, 1.0f, 1.0f, rot);
}
__device__ __forceinline__ void cvt_matrix8(const Ctx& X, const float* W, int K, int N, unsigned char* dst, size_t dpitch, const float* gain, float scale, int rot) {
    cvt_run<true, false>(X, W, nullptr, K, N, N, dst, dpitch, 0, 0, gain, 0, 1.0f, scale, rot);
}
__device__ __forceinline__ void cvt_gateup8(const Ctx& X, const float* Wg, const float* Wu, unsigned char* dst, const float* gain, float scale, int rot) {
    cvt_run<true, true>(X, Wg, Wu, DM, DFF, DFF, dst, (size_t)DM, 0, 0, gain, 0, 1.0f, scale, rot);
}
__device__ __forceinline__ void row_rmsnorm_to_bf16(const float* xrow, bf16_t* orow, int lane, unsigned char* orow8 = nullptr) {
    f32x4 v[8]; float s = 0.f;
#pragma unroll
    for (int j = 0; j < 8; ++j) { v[j] = *(const f32x4*)(xrow + j * 256 + lane * 4); s += (v[j][0] * v[j][0] + v[j][1] * v[j][1]) + (v[j][2] * v[j][2] + v[j][3] * v[j][3]); }
    const float rstd = 1.0f / sqrtf(wave_sum(s) * (1.0f / DM) + EPS);
#pragma unroll
    for (int j = 0; j < 8; ++j) { u32x2 w; w.x = pk2(v[j][0] * rstd, v[j][1] * rstd); w.y = pk2(v[j][2] * rstd, v[j][3] * rstd); *(u32x2*)(orow + j * 256 + lane * 4) = w;
        if (orow8) *(unsigned*)(orow8 + j * 256 + lane * 4) = pk4_fp8(v[j][0] * rstd, v[j][1] * rstd, v[j][2] * rstd, v[j][3] * rstd); }
}
__device__ __forceinline__ bool cvt_deferred(int G) { return ONE_LAUNCH && G >= 192; }
__device__ __forceinline__ void phase_prologue(const Ctx& X, const Params& p) {
    TID_INIT();
    unsigned char* ws = X.ws;
    int rot = 0;
    for (int l = 0; l < DEPTH; ++l) {
        cvt_run<false, false>(X, p.w_in + (size_t)l * DM * NIN, nullptr, DM, NIN16, NIN, ws + WS_WIN + (size_t)l * NIN16 * DM * 2, (size_t)DM * 2, 0, 0, p.g_pre_mix + l * DM, 1024, 0.08838834764831845f, 1.0f, rot); rot += 37;
        cvt_run<true, false>(X, p.w_in + (size_t)l * DM * NIN + NIN16, nullptr, DM, NIN8, NIN, ws + WS_WIN8 + (size_t)l * NIN8 * DM, (size_t)DM, 0, 0, p.g_pre_mix + l * DM, 0, 1.0f, WSC8, rot); rot += 37;
        for (int n = 0; n < 3; ++n) { cvt_matrix(X, p.w_branch + ((size_t)l * 3 + n) * 1024 * DM, 1024, DM, (bf16_t*)(ws + WS_WBR) + ((size_t)l * 3 + n) * DM * 1024, 1024, 0, 0, nullptr, 0, 1.0f, rot); rot += 37; }
        cvt_matrix(X, p.w_mix + (size_t)l * DM * DM, DM, DM, (bf16_t*)(ws + WS_WMIX) + (size_t)l * DM * DM, DM, 0, 0, nullptr, 0, 1.0f, rot); rot += 37;
        cvt_matrix(X, p.w_xq + (size_t)l * DM * 512, DM, 512, (bf16_t*)(ws + WS_WXQ) + (size_t)l * 512 * DM, DM, 0, 0, p.g_pre_x + l * DM, 0, 1.0f, rot); rot += 37;
        cvt_matrix(X, p.w_xkv + (size_t)l * DM * 1024, DM, 1024, (bf16_t*)(ws + WS_WXKV), DM, l * 1024, 0, p.g_mem + l * DM, 0, 1.0f, rot); rot += 37;
        cvt_matrix(X, p.w_xo + (size_t)l * 512 * DM, 512, DM, (bf16_t*)(ws + WS_WXO) + (size_t)l * DM * 512, 512, 0, 0, nullptr, 0, 1.0f, rot); rot += 37;
    }
    if (FFN_GU_FP8) cvt_gateup8(X, p.w_fg, p.w_fu, ws + WS_WGU, p.g_pre_ffn, WSC8, rot);
    else cvt_gateup(X, p.w_fg, p.w_fu, (bf16_t*)(ws + WS_WGU), p.g_pre_ffn, rot);
    rot += 37;
    cvt_matrix8(X, p.w_fd, DFF, DM, ws + WS_WDN, DFF, nullptr, WSC8, rot); rot += 37;
    for (int e = 0; e < NEXP; ++e) {
        if (!(cvt_deferred(X.G) && e >= NEXP - 2)) cvt_gateup8(X, p.w_eg + (size_t)e * DM * DFF, p.w_eu + (size_t)e * DM * DFF, ws + WS_WEGU + (size_t)e * 14336 * DM, p.g_pre_ffn + DM, WSC8, rot);
        rot += 37;
        cvt_matrix8(X, p.w_ed + (size_t)e * DFF * DM, DFF, DM, ws + WS_WEDN + (size_t)e * DM * DFF, DFF, nullptr, WSC8, rot); rot += 37;
    }
    if (X.dry) return;
    { float* cs = (float*)(ws + WS_ROPE); float* sn = cs + (size_t)S * 64;
      for (int i = X.c * 512 + tid; i < S * 64; i += X.G * 512) { const int pos = i >> 6, k = i & 63;
          const float inv = exp2f(-(float)k * (13.287712379549449f / 64.0f)); const float ang = (float)pos * inv; float sv, cv; sincosf(ang, &sv, &cv); cs[i] = cv; sn[i] = sv; } }
    for (int m = gw; m < MEM_LEN; m += NGW) row_rmsnorm_to_bf16(p.mem + (size_t)m * DM, (bf16_t*)(ws + WS_MEMN) + (size_t)m * DM, lane);
    for (int m = gw; m < S; m += NGW) row_rmsnorm_to_bf16(p.x + (size_t)m * DM, (bf16_t*)(ws + WS_H) + (size_t)m * DM, lane, ws + WS_H8 + (size_t)m * DM);
}

constexpr int XBP = 2 * DM;
struct RouteRec { int e1, e2; float g1, g2; int s1, s2, pad0, pad1; };
template <int MODE, bool ROUTE, bool LAST, bool XS, bool XD>
__device__ __forceinline__ void phase_norm(const Ctx& X, const float* xsrc, float* xdst, const bf16_t* Y, const float* gpost, bf16_t* H,
                                           const float* w_router, const float* gpre, RouteRec* rr, int* hist, unsigned char* H8 = nullptr) {
    TID_INIT();
    LAS float* wr_l = (LAS float*)X.lds;
    LAS int* cnt_l = (LAS int*)(X.lds + 65536);
    if (ROUTE) {
        for (int i = tid; i < DM * NEXP; i += 512) wr_l[i] = w_router[i] * gpre[i >> 3];
        if (tid < 8) cnt_l[tid] = 0;
        __syncthreads();
    }
    const int rstep = X.G, rend = S;
    f32x4 Ax[8], Bx[8]; u32x2 Axb[8], Bxb[8]; u32x2 Ay1[8], By1[8], Ay2[8], By2[8]; float Ag1 = 0.f, Ag2 = 0.f, Bg1 = 0.f, Bg2 = 0.f;
#define NLOAD(R, row_) do { const int r_ = (row_); const bf16_t* y1_ = Y + (size_t)r_ * DM; const bf16_t* y2_ = Y; \
        if (MODE == 1) { const RouteRec q_ = rr[r_]; R##g1 = q_.g1; R##g2 = q_.g2; y1_ = Y + (size_t)q_.s1 * DM; y2_ = Y + (size_t)q_.s2 * DM; } \
        _Pragma("unroll") for (int j = 0; j < 8; ++j) { if (XS) R##xb[j] = *(const u32x2*)((const bf16_t*)xsrc + (size_t)r_ * XBP + j * 256 + lane * 4); else R##x[j] = *(const f32x4*)(xsrc + (size_t)r_ * DM + j * 256 + lane * 4); R##y1[j] = *(const u32x2*)(y1_ + j * 256 + lane * 4); \
            if (MODE == 1) R##y2[j] = *(const u32x2*)(y2_ + j * 256 + lane * 4); } \
        asm volatile("" ::: "memory"); } while (0)
#define NPROC(R, row_) do { const int rw_ = (row_); f32x4 yv[8]; float s = 0.f; \
        _Pragma("unroll") for (int j = 0; j < 8; ++j) { yv[j] = (f32x4){bf2f(R##y1[j].x & 0xffffu), bf2f(R##y1[j].x >> 16), bf2f(R##y1[j].y & 0xffffu), bf2f(R##y1[j].y >> 16)}; \
            if (MODE == 1) yv[j] = yv[j] * R##g1 + (f32x4){bf2f(R##y2[j].x & 0xffffu), bf2f(R##y2[j].x >> 16), bf2f(R##y2[j].y & 0xffffu), bf2f(R##y2[j].y >> 16)} * R##g2; \
            s += (yv[j][0] * yv[j][0] + yv[j][1] * yv[j][1]) + (yv[j][2] * yv[j][2] + yv[j][3] * yv[j][3]); } \
        const float rstd = 1.0f / sqrtf(wave_sum(s) * (1.0f / DM) + EPS); float s2 = 0.f; \
        _Pragma("unroll") for (int j = 0; j < 8; ++j) { const f32x4 g = *(const f32x4*)(gpost + j * 256 + lane * 4); if (XS) R##x[j] = (f32x4){bf2f(R##xb[j].x & 0xffffu), bf2f(R##xb[j].x >> 16), bf2f(R##xb[j].y & 0xffffu), bf2f(R##xb[j].y >> 16)}; \
            R##x[j] = R##x[j] + yv[j] * rstd * g; \
            if (XD) { u32x2 w_; w_.x = pk2(R##x[j][0], R##x[j][1]); w_.y = pk2(R##x[j][2], R##x[j][3]); *(u32x2*)((bf16_t*)xdst + (size_t)rw_ * XBP + j * 256 + lane * 4) = w_; } \
            else *(f32x4*)(xdst + (size_t)rw_ * DM + j * 256 + lane * 4) = R##x[j]; \
            s2 += (R##x[j][0] * R##x[j][0] + R##x[j][1] * R##x[j][1]) + (R##x[j][2] * R##x[j][2] + R##x[j][3] * R##x[j][3]); } \
        if (!LAST) { const float rstd2 = 1.0f / sqrtf(wave_sum(s2) * (1.0f / DM) + EPS); \
            _Pragma("unroll") for (int j = 0; j < 8; ++j) { R##x[j] = R##x[j] * rstd2; \
                if (ROUTE) { *(unsigned*)((unsigned char*)H + (size_t)rw_ * DM + j * 256 + lane * 4) = pk4_fp8(R##x[j][0], R##x[j][1], R##x[j][2], R##x[j][3]); } \
                else { if (H) { u32x2 w; w.x = pk2(R##x[j][0], R##x[j][1]); w.y = pk2(R##x[j][2], R##x[j][3]); *(u32x2*)(H + (size_t)rw_ * DM + j * 256 + lane * 4) = w; } \
                    if (H8) *(unsigned*)(H8 + (size_t)rw_ * DM + j * 256 + lane * 4) = pk4_fp8(R##x[j][0], R##x[j][1], R##x[j][2], R##x[j][3]); } } \
            if (ROUTE) { float lg[8] = {0.f, 0.f, 0.f, 0.f, 0.f, 0.f, 0.f, 0.f}; \
                _Pragma("unroll") for (int j = 0; j < 8; ++j) _Pragma("unroll") for (int q = 0; q < 4; ++q) { const int k = j * 256 + lane * 4 + q; \
                    const f32x4 a = *(const LAS f32x4*)(wr_l + k * 8), b = *(const LAS f32x4*)(wr_l + k * 8 + 4); const float xx = R##x[j][q]; \
                    lg[0] += xx * a[0]; lg[1] += xx * a[1]; lg[2] += xx * a[2]; lg[3] += xx * a[3]; lg[4] += xx * b[0]; lg[5] += xx * b[1]; lg[6] += xx * b[2]; lg[7] += xx * b[3]; } \
                _Pragma("unroll") for (int e = 0; e < 8; ++e) lg[e] = wave_sum(lg[e]); \
                int e1 = 0; float v1 = lg[0]; \
                _Pragma("unroll") for (int e = 1; e < 8; ++e) if (lg[e] > v1) { v1 = lg[e]; e1 = e; } \
                int e2 = -1; float v2 = -__builtin_inff(); \
                _Pragma("unroll") for (int e = 0; e < 8; ++e) if (e != e1 && lg[e] > v2) { v2 = lg[e]; e2 = e; } \
                const float ex = __expf(v2 - v1); const float ga = 1.0f / (1.0f + ex), gb = ex / (1.0f + ex); \
                if (lane == 0) { RouteRec r; r.e1 = e1; r.e2 = e2; r.g1 = ga; r.g2 = gb; r.s1 = 0; r.s2 = 0; r.pad0 = 0; r.pad1 = 0; rr[rw_] = r; atomicAdd((int*)cnt_l + e1, 1); atomicAdd((int*)cnt_l + e2, 1); } } } \
        } while (0)
    int row = X.c + rstep * wave;
    if (row < rend) NLOAD(A, row);
    for (; row < rend; row += 16 * rstep) {
        if (row + 8 * rstep < rend) NLOAD(B, row + 8 * rstep);
        NPROC(A, row);
        if (row + 16 * rstep < rend) NLOAD(A, row + 16 * rstep);
        if (row + 8 * rstep < rend) NPROC(B, row + 8 * rstep);
    }
#undef NLOAD
#undef NPROC
    if (ROUTE) { __syncthreads(); if (tid < 8) hist[X.c * 8 + tid] = cnt_l[tid]; }
}

__device__ __forceinline__ void phase_assign(const Ctx& X, RouteRec* rr, const int* hist, int* tstart_g, int* slottok, const unsigned char* H8, unsigned char* HP8) {
    TID_INIT();
    LAS int* hl = (LAS int*)X.lds;
    LAS int* base_l = hl + 4096;
    LAS int* seg_l = base_l + 8;
    LAS int* slot_l = seg_l + 32;
    LAS int* ex_l = slot_l + 1024;
    const int rpw = (S + X.G - 1) / X.G;
    for (int i = tid; i < X.G * 8; i += 512) hl[i] = hist[i];
    for (int ri = tid; ri < rpw; ri += 512) { const int row = X.c + X.G * ri; int e1 = -1, e2 = -1; if (row < S) { e1 = rr[row].e1; e2 = rr[row].e2; } ex_l[ri * 2] = e1; ex_l[ri * 2 + 1] = e2; }
    __syncthreads();
    if (tid < 8) { int tot = 0, before = 0; for (int c = 0; c < X.G; ++c) { const int v = hl[c * 8 + tid]; if (c < X.c) before += v; tot += v; } seg_l[16 + tid] = tot; base_l[tid] = before; }
    __syncthreads();
    if (tid == 0) { int t = 0; for (int e = 0; e < 8; ++e) { seg_l[e] = t * 256; if (X.c == 0) tstart_g[e] = t; t += (seg_l[16 + e] + 255) >> 8; } seg_l[8] = t * 256; if (X.c == 0) tstart_g[8] = t; }
    __syncthreads();
    if (tid < 8) { const int e = tid; int pos = seg_l[e] + base_l[e];
        for (int ri = 0; ri < rpw; ++ri) { if (ex_l[ri * 2] == e) { slot_l[ri * 2] = pos; ++pos; } if (ex_l[ri * 2 + 1] == e) { slot_l[ri * 2 + 1] = pos; ++pos; } } }
    if (X.c < 8) { const int e = X.c; const int lo = seg_l[e] + seg_l[16 + e], hi = seg_l[e + 1]; for (int i = lo + tid; i < hi; i += 512) slottok[i] = 0; }
    __syncthreads();
    for (int ri = tid; ri < rpw; ri += 512) { const int row = X.c + X.G * ri; if (row < S) { const int s1 = slot_l[ri * 2], s2 = slot_l[ri * 2 + 1]; rr[row].s1 = s1; rr[row].s2 = s2; slottok[s1] = row; slottok[s2] = row; } }
    for (int ri = wave; ri < rpw; ri += 8) { const int row = X.c + X.G * ri; if (row >= S) break;
        const u32x4 a = *(const u32x4*)(H8 + (size_t)row * DM + lane * 32), b = *(const u32x4*)(H8 + (size_t)row * DM + lane * 32 + 16);
        const int s1 = slot_l[ri * 2], s2 = slot_l[ri * 2 + 1];
        *(u32x4*)(HP8 + (size_t)s1 * DM + lane * 32) = a; *(u32x4*)(HP8 + (size_t)s1 * DM + lane * 32 + 16) = b;
        *(u32x4*)(HP8 + (size_t)s2 * DM + lane * 32) = a; *(u32x4*)(HP8 + (size_t)s2 * DM + lane * 32 + 16) = b; }
}

constexpr int TAIL_MAX = 64;
__device__ __forceinline__ int moe_tail_units(const int* tstart, int G) { const int nun = tstart[8] * (DM / 256); int T = nun % G; if (!ONE_LAUNCH || T > TAIL_MAX) T = 0; return T; }
__device__ __forceinline__ void phase_tailfix(const Ctx& X, const int* tstart, const bf16_t* YP, bf16_t* YS) {
    TID_INIT();
    const int T = moe_tail_units(tstart, X.G); if (T == 0) return;
    pg8::MoeOrder<false> mo; mo.init(tstart, DM, X.G, X.c, nullptr); const int first = mo.nwg - T;
    for (int g = X.c * 512 + tid; g < T * 8192; g += X.G * 512) { const int j = g >> 13, r = (g >> 5) & 255, c8 = g & 31; pg8::Unit u; mo.unit_of(first + j, u);
        float a[8] = {0.f, 0.f, 0.f, 0.f, 0.f, 0.f, 0.f, 0.f};
#pragma unroll
        for (int ks = 0; ks < pg8::MoeTailOrder::NSL; ++ks) { const u32x4 w = *(const u32x4*)(YP + ((size_t)(j * pg8::MoeTailOrder::NSL + ks) << 16) + r * 256 + c8 * 8);
            a[0] += bf2f(w.x & 0xffffu); a[1] += bf2f(w.x >> 16); a[2] += bf2f(w.y & 0xffffu); a[3] += bf2f(w.y >> 16); a[4] += bf2f(w.z & 0xffffu); a[5] += bf2f(w.z >> 16); a[6] += bf2f(w.w & 0xffffu); a[7] += bf2f(w.w >> 16); }
        u32x4 o; o.x = pk2(a[0], a[1]); o.y = pk2(a[2], a[3]); o.z = pk2(a[4], a[5]); o.w = pk2(a[6], a[7]);
        *(u32x4*)(YS + (size_t)(u.pm * 256 + r) * DM + u.pn * 256 + c8 * 8) = o; }
}

__device__ __forceinline__ void unpack8(const u32x4 w, float (&f)[8]) {
    f[0] = bf2f(w.x & 0xffffu); f[1] = bf2f(w.x >> 16); f[2] = bf2f(w.y & 0xffffu); f[3] = bf2f(w.y >> 16);
    f[4] = bf2f(w.z & 0xffffu); f[5] = bf2f(w.z >> 16); f[6] = bf2f(w.w & 0xffffu); f[7] = bf2f(w.w >> 16);
}
__device__ __forceinline__ void phase_conv(const Ctx& X, const bf16_t* P, const float* wconv, bf16_t* Y3) {
    TID_INIT();
    for (int it = X.c * 512 + tid; it < (S / 4) * 128; it += X.G * 512) { const int oct = it & 31, tl = (it >> 5) & 3, t0 = (it >> 7) * 4, w0 = tl * 256 + oct * 8;
        const bf16_t* pc = P + pidx(0, C_CC + w0); const bf16_t* pu = P + pidx(0, C_CU + w0); const bf16_t* pb = P + pidx(0, C_CB + w0);
        u32x4 cr[6], ur[6], br[4];
#pragma unroll
        for (int j = 0; j < 6; ++j) { const int tt = t0 - 2 + j, tc = tt < 0 ? 0 : tt; cr[j] = *(const u32x4*)(pc + (size_t)tc * 256); ur[j] = *(const u32x4*)(pu + (size_t)tc * 256); }
#pragma unroll
        for (int j = 0; j < 4; ++j) br[j] = *(const u32x4*)(pb + (size_t)(t0 + j) * 256);
        float wv[3][8];
#pragma unroll
        for (int j = 0; j < 3; ++j) { const f32x4 wa = *(const f32x4*)(wconv + j * 1024 + w0), wb = *(const f32x4*)(wconv + j * 1024 + w0 + 4);
#pragma unroll
            for (int q = 0; q < 4; ++q) { wv[j][q] = wa[q]; wv[j][4 + q] = wb[q]; } }
        float v[6][8];
#pragma unroll
        for (int j = 0; j < 6; ++j) { float c[8], u[8]; unpack8(cr[j], c); unpack8(ur[j], u); const float msk = (t0 - 2 + j) < 0 ? 0.f : 1.f;
#pragma unroll
            for (int q = 0; q < 8; ++q) v[j][q] = c[q] * u[q] * msk; }
#pragma unroll
        for (int j = 0; j < 4; ++j) { float bb[8]; unpack8(br[j], bb); float r[8];
#pragma unroll
            for (int q = 0; q < 8; ++q) r[q] = bb[q] * (wv[0][q] * v[j][q] + wv[1][q] * v[j + 1][q] + wv[2][q] * v[j + 2][q]);
            u32x4 o; o.x = pk2(r[0], r[1]); o.y = pk2(r[2], r[3]); o.z = pk2(r[4], r[5]); o.w = pk2(r[6], r[7]);
            *(u32x4*)(Y3 + (size_t)S * 1024 + (size_t)(t0 + j) * 1024 + w0) = o; } }
}

__device__ __forceinline__ int tr_addr(int lane, int pitch) { const int g = lane >> 4, i = lane & 15; return ((g >> 1) * 8 + (i >> 2)) * pitch + ((g & 1) * 16 + (i & 3) * 4) * 2; }
#define TR_READ2(lo, hi, addr, off_lo, off_hi) do { asm volatile("ds_read_b64_tr_b16 %0, %1 offset:%2" : "=&v"(lo) : "v"(addr), "i"(off_lo) : "memory"); \
                                                     asm volatile("ds_read_b64_tr_b16 %0, %1 offset:%2" : "=&v"(hi) : "v"(addr), "i"(off_hi) : "memory"); } while (0)
constexpr int RP_T = 320;
constexpr int RP_R = 272;
__device__ __forceinline__ float ret_logg(int h) { return log1pf(-exp2f(-5.0f - (float)h)); }
__device__ __forceinline__ void rope8(const u32x4 w1, const u32x4 w2, const float* cs, const float* sn, float scale, u32x4& o1, u32x4& o2) {
    float a[8], b[8]; unpack8(w1, a); unpack8(w2, b);
    const f32x4 c0 = *(const f32x4*)cs, c1 = *(const f32x4*)(cs + 4), s0 = *(const f32x4*)sn, s1 = *(const f32x4*)(sn + 4);
    float r1[8], r2[8];
#pragma unroll
    for (int q = 0; q < 4; ++q) { r1[q] = (a[q] * c0[q] - b[q] * s0[q]) * scale; r2[q] = (a[q] * s0[q] + b[q] * c0[q]) * scale;
        r1[4 + q] = (a[4 + q] * c1[q] - b[4 + q] * s1[q]) * scale; r2[4 + q] = (a[4 + q] * s1[q] + b[4 + q] * c1[q]) * scale; }
    o1.x = pk2(r1[0], r1[1]); o1.y = pk2(r1[2], r1[3]); o1.z = pk2(r1[4], r1[5]); o1.w = pk2(r1[6], r1[7]);
    o2.x = pk2(r2[0], r2[1]); o2.y = pk2(r2[2], r2[3]); o2.z = pk2(r2[4], r2[5]); o2.w = pk2(r2[6], r2[7]);
}
__device__ __forceinline__ void phase_ret_kv(const Ctx& X, const bf16_t* P, const float* rope_cs, float* KVS) {
    LAS unsigned char* kd_l = X.lds;
    LAS unsigned char* v_l = X.lds + 128 * RP_T;
    TID_INIT();
    const float* rope_sn = rope_cs + (size_t)S * 64;
    const int w = wave, r32 = lane & 31, hi = lane >> 5;
    for (int u = X.c; u < 1024; u += X.G) { const int n = u >> 3, h = u & 7, t0 = n * 128; const float lg = ret_logg(h);
#pragma unroll
        for (int ii = 0; ii < 2; ++ii) { const int pi = tid + 512 * ii, j = pi >> 3, d0 = (pi & 7) * 8; const bf16_t* kp = P + pidx(t0 + j, C_RK + h * 128 + d0);
            u32x4 o1, o2; rope8(*(const u32x4*)kp, *(const u32x4*)(kp + 64), rope_cs + (size_t)(t0 + j) * 64 + d0, rope_sn + (size_t)(t0 + j) * 64 + d0, __expf((float)(127 - j) * lg), o1, o2);
            *(LAS u32x4*)(kd_l + j * RP_T + d0 * 2) = o1; *(LAS u32x4*)(kd_l + j * RP_T + (d0 + 64) * 2) = o2; }
#pragma unroll
        for (int ii = 0; ii < 4; ++ii) { const int pi = tid + 512 * ii, j = pi >> 4, e0 = (pi & 15) * 8;
            *(LAS u32x4*)(v_l + j * RP_T + e0 * 2) = *(const u32x4*)(P + pidx(t0 + j, C_RV + h * 128 + e0)); }
        LDS_WAIT(); __syncthreads();
        const int db = w >> 1, eb0 = (w & 1) * 2;
        f32x16 c0 = {}, c1 = {};
        const int ta = (int)(uintptr_t)(kd_l) + tr_addr(lane, RP_T) + db * 64, tb = (int)(uintptr_t)(v_l) + tr_addr(lane, RP_T) + eb0 * 64;
#define RKV_STEP(ks) do { s16x4 al, ah, bl0, bh0, bl1, bh1; \
            TR_READ2(al, ah, ta, (ks) * 16 * RP_T, (ks) * 16 * RP_T + 4 * RP_T); TR_READ2(bl0, bh0, tb, (ks) * 16 * RP_T, (ks) * 16 * RP_T + 4 * RP_T); TR_READ2(bl1, bh1, tb, (ks) * 16 * RP_T + 64, (ks) * 16 * RP_T + 4 * RP_T + 64); \
            LDS_WAIT(); __builtin_amdgcn_sched_barrier(0); \
            const bf16x8 af = {al[0], al[1], al[2], al[3], ah[0], ah[1], ah[2], ah[3]}; \
            c0 = __builtin_amdgcn_mfma_f32_32x32x16_bf16(af, (bf16x8){bl0[0], bl0[1], bl0[2], bl0[3], bh0[0], bh0[1], bh0[2], bh0[3]}, c0, 0, 0, 0); \
            c1 = __builtin_amdgcn_mfma_f32_32x32x16_bf16(af, (bf16x8){bl1[0], bl1[1], bl1[2], bl1[3], bh1[0], bh1[1], bh1[2], bh1[3]}, c1, 0, 0, 0); } while (0)
        RKV_STEP(0); RKV_STEP(1); RKV_STEP(2); RKV_STEP(3); RKV_STEP(4); RKV_STEP(5); RKV_STEP(6); RKV_STEP(7);
#undef RKV_STEP
        float* outp = KVS + (size_t)u * 16384;
#pragma unroll
        for (int r = 0; r < 16; ++r) { const int d = db * 32 + att::crow(r, hi); outp[d * 128 + eb0 * 32 + r32] = c0[r]; outp[d * 128 + (eb0 + 1) * 32 + r32] = c1[r]; }
        __syncthreads();
    }
}
__device__ __forceinline__ void phase_ret_scan(const Ctx& X, const float* KVS, bf16_t* PRV) {
    TID_INIT();
    for (int idx = X.c * 512 + tid; idx < 8 * 16384; idx += X.G * 512) { const int h = idx >> 14, ed = idx & 16383; const float cd = __expf(128.0f * ret_logg(h));
        float st = 0.f;
        for (int n0 = 0; n0 < 128; n0 += 16) { float kv[16];
#pragma unroll
            for (int q = 0; q < 16; ++q) kv[q] = KVS[((size_t)((n0 + q) * 8 + h) << 14) + ed];
#pragma unroll
            for (int q = 0; q < 16; ++q) { PRV[((size_t)((n0 + q) * 8 + h) << 14) + ed] = (bf16_t)f2bf(st); st = st * cd + kv[q]; } } }
}
__device__ __forceinline__ void phase_ret_out(const Ctx& X, const bf16_t* P, const float* rope_cs, const bf16_t* PRV, bf16_t* Y3) {
    LAS unsigned char* q_l = X.lds;
    LAS unsigned char* k_l = X.lds + 128 * RP_R;
    LAS unsigned char* v_l = X.lds + 2 * 128 * RP_R;
    LAS unsigned char* s_l = v_l + 128 * RP_T;
    LAS float* o_l = (LAS float*)X.lds;
    static_assert(2 * 128 * RP_R + 2 * 128 * RP_T <= LDS_CTL_OFF && 128 * 132 * 4 <= 2 * 128 * RP_R, "retention LDS map");
    TID_INIT();
    const float* rope_sn = rope_cs + (size_t)S * 64;
    const int w = wave, r32 = lane & 31, hi = lane >> 5;
    for (int u = X.c; u < 1024; u += X.G) { const int n = u >> 3, h = u & 7, t0 = n * 128; const float lg = ret_logg(h);
#pragma unroll
        for (int ii = 0; ii < 2; ++ii) { const int pi = tid + 512 * ii, j = pi >> 3, d0 = (pi & 7) * 8; const size_t ro = pidx(t0 + j, h * 128 + d0);
            const float* cs = rope_cs + (size_t)(t0 + j) * 64 + d0; const float* sn = rope_sn + (size_t)(t0 + j) * 64 + d0; u32x4 o1, o2;
            rope8(*(const u32x4*)(P + ro + C_RQ), *(const u32x4*)(P + ro + C_RQ + 64), cs, sn, 1.0f, o1, o2);
            *(LAS u32x4*)(q_l + j * RP_R + d0 * 2) = o1; *(LAS u32x4*)(q_l + j * RP_R + (d0 + 64) * 2) = o2;
            rope8(*(const u32x4*)(P + ro + (size_t)4 * S * 256), *(const u32x4*)(P + ro + (size_t)4 * S * 256 + 64), cs, sn, 1.0f, o1, o2);
            *(LAS u32x4*)(k_l + j * RP_R + d0 * 2) = o1; *(LAS u32x4*)(k_l + j * RP_R + (d0 + 64) * 2) = o2; }
#pragma unroll
        for (int ii = 0; ii < 4; ++ii) { const int pi = tid + 512 * ii, j = pi >> 4, e0 = (pi & 15) * 8;
            *(LAS u32x4*)(v_l + j * RP_T + e0 * 2) = *(const u32x4*)(P + pidx(t0 + j, C_RV + h * 128 + e0));
            *(LAS u32x4*)(s_l + j * RP_T + e0 * 2) = *(const u32x4*)(PRV + (size_t)u * 16384 + j * 128 + e0); }
        LDS_WAIT(); __syncthreads();
        const int ib = w >> 1, jb0 = (w & 1) * 2;
        f32x16 s0 = {}, s1 = {};
#pragma unroll
        for (int ks = 0; ks < 8; ++ks) { const bf16x8 a = *(const LAS bf16x8*)(q_l + (ib * 32 + r32) * RP_R + (ks * 16 + hi * 8) * 2);
            const bf16x8 b0 = *(const LAS bf16x8*)(k_l + (jb0 * 32 + r32) * RP_R + (ks * 16 + hi * 8) * 2), b1 = *(const LAS bf16x8*)(k_l + ((jb0 + 1) * 32 + r32) * RP_R + (ks * 16 + hi * 8) * 2);
            s0 = __builtin_amdgcn_mfma_f32_32x32x16_bf16(a, b0, s0, 0, 0, 0); s1 = __builtin_amdgcn_mfma_f32_32x32x16_bf16(a, b1, s1, 0, 0, 0); }
        __syncthreads();
#pragma unroll
        for (int r = 0; r < 16; ++r) { const int i = ib * 32 + att::crow(r, hi); const int j0 = jb0 * 32 + r32, j1 = j0 + 32;
            const float p0 = (i >= j0) ? s0[r] * __expf((float)(i - j0) * lg) : 0.f, p1 = (i >= j1) ? s1[r] * __expf((float)(i - j1) * lg) : 0.f;
            *(LAS bf16_t*)(k_l + i * RP_R + j0 * 2) = (bf16_t)f2bf(p0); *(LAS bf16_t*)(k_l + i * RP_R + j1 * 2) = (bf16_t)f2bf(p1); }
        LDS_WAIT(); __syncthreads();
        const int eb0 = (w & 1) * 2;
        f32x16 a0 = {}, a1 = {}, x0 = {}, x1 = {};
        const int tv = (int)(uintptr_t)(v_l) + tr_addr(lane, RP_T) + eb0 * 64, tsx = (int)(uintptr_t)(s_l) + tr_addr(lane, RP_T) + eb0 * 64;
#define ROUT_STEP(ks) do { s16x4 bl0, bh0, bl1, bh1, cl0, ch0, cl1, ch1; \
            TR_READ2(bl0, bh0, tv, (ks) * 16 * RP_T, (ks) * 16 * RP_T + 4 * RP_T); TR_READ2(bl1, bh1, tv, (ks) * 16 * RP_T + 64, (ks) * 16 * RP_T + 4 * RP_T + 64); \
            TR_READ2(cl0, ch0, tsx, (ks) * 16 * RP_T, (ks) * 16 * RP_T + 4 * RP_T); TR_READ2(cl1, ch1, tsx, (ks) * 16 * RP_T + 64, (ks) * 16 * RP_T + 4 * RP_T + 64); \
            const bf16x8 pa = *(const LAS bf16x8*)(k_l + (ib * 32 + r32) * RP_R + ((ks) * 16 + hi * 8) * 2), qa = *(const LAS bf16x8*)(q_l + (ib * 32 + r32) * RP_R + ((ks) * 16 + hi * 8) * 2); \
            LDS_WAIT(); __builtin_amdgcn_sched_barrier(0); \
            a0 = __builtin_amdgcn_mfma_f32_32x32x16_bf16(pa, (bf16x8){bl0[0], bl0[1], bl0[2], bl0[3], bh0[0], bh0[1], bh0[2], bh0[3]}, a0, 0, 0, 0); \
            a1 = __builtin_amdgcn_mfma_f32_32x32x16_bf16(pa, (bf16x8){bl1[0], bl1[1], bl1[2], bl1[3], bh1[0], bh1[1], bh1[2], bh1[3]}, a1, 0, 0, 0); \
            x0 = __builtin_amdgcn_mfma_f32_32x32x16_bf16(qa, (bf16x8){cl0[0], cl0[1], cl0[2], cl0[3], ch0[0], ch0[1], ch0[2], ch0[3]}, x0, 0, 0, 0); \
            x1 = __builtin_amdgcn_mfma_f32_32x32x16_bf16(qa, (bf16x8){cl1[0], cl1[1], cl1[2], cl1[3], ch1[0], ch1[1], ch1[2], ch1[3]}, x1, 0, 0, 0); } while (0)
        ROUT_STEP(0); ROUT_STEP(1); ROUT_STEP(2); ROUT_STEP(3); ROUT_STEP(4); ROUT_STEP(5); ROUT_STEP(6); ROUT_STEP(7);
#undef ROUT_STEP
        __syncthreads();
#pragma unroll
        for (int r = 0; r < 16; ++r) { const int i = ib * 32 + att::crow(r, hi); const float qd = __expf((float)(i + 1) * lg);
            o_l[i * 132 + eb0 * 32 + r32] = a0[r] + qd * x0[r]; o_l[i * 132 + (eb0 + 1) * 32 + r32] = a1[r] + qd * x1[r]; }
        LDS_WAIT(); __syncthreads();
        for (int ri = 0; ri < 16; ++ri) { const int i = w * 16 + ri; const f32x2 v = *(const LAS f32x2*)(o_l + i * 132 + lane * 2);
            const float rstd = 1.0f / sqrtf(wave_sum(v[0] * v[0] + v[1] * v[1]) * (1.0f / 128.0f) + EPS);
            const unsigned gw = *(const unsigned*)(P + pidx(t0 + i, C_RG + h * 128 + lane * 2));
            *(unsigned*)(Y3 + (size_t)(t0 + i) * 1024 + h * 128 + lane * 2) = pk2(bf2f(gw & 0xffffu) * v[0] * rstd, bf2f(gw >> 16) * v[1] * rstd); }
        __syncthreads();
    }
}

__device__ __forceinline__ void phase_diff_combine(const Ctx& X, const bf16_t* OT, const float* dlam, const float* dsub, float lam_init, bf16_t* Y3) {
    TID_INIT();
    float d1 = dlam[lane] * dlam[128 + lane] + dlam[64 + lane] * dlam[128 + 64 + lane];
    float d2 = dlam[256 + lane] * dlam[384 + lane] + dlam[256 + 64 + lane] * dlam[384 + 64 + lane];
    const float lam = __expf(wave_sum(d1)) - __expf(wave_sum(d2)) + lam_init;
    const f32x4 sg = *(const f32x4*)(dsub + lane * 4);
    for (int it = gw; it < S * 4; it += NGW) { const int t = it >> 2, h = it & 3;
        const u32x2 w0 = *(const u32x2*)(OT + (size_t)t * 2048 + h * 512 + lane * 4), w1 = *(const u32x2*)(OT + (size_t)t * 2048 + h * 512 + 256 + lane * 4);
        f32x4 o = (f32x4){bf2f(w0.x & 0xffffu), bf2f(w0.x >> 16), bf2f(w0.y & 0xffffu), bf2f(w0.y >> 16)} - (f32x4){bf2f(w1.x & 0xffffu), bf2f(w1.x >> 16), bf2f(w1.y & 0xffffu), bf2f(w1.y >> 16)} * lam;
        const float rstd = 1.0f / sqrtf(wave_sum((o[0] * o[0] + o[1] * o[1]) + (o[2] * o[2] + o[3] * o[3])) * (1.0f / 256.0f) + EPS) * (1.0f - lam_init);
        o = o * rstd * sg; u32x2 w; w.x = pk2(o[0], o[1]); w.y = pk2(o[2], o[3]);
        *(u32x2*)(Y3 + (size_t)2 * S * 1024 + (size_t)t * 1024 + h * 256 + lane * 4) = w; }
}

__device__ __forceinline__ att2::Blk diff_blk(const bf16_t* P, bf16_t* OT, const float* bias_l, int L, int pass) {
    const int hm = (L & 7), x = (L >> 3) & 63, qb = pass ? 127 - x : x; const int h = hm >> 1, m = hm & 1;
    att2::Blk r;
    r.Q = P + pidx(qb * 128, C_DQ + h * 256 + m * 128); r.K = P + pidx(0, C_DK + h * 256 + m * 128); r.V = P + pidx(0, C_DV + h * 256);
    r.O = OT + (size_t)qb * 128 * 2048 + h * 512 + m * 256; r.P0 = qb * 128; r.btab = bias_l + h * 128; return r;
}
__device__ __forceinline__ void phase_diff_attn(const Ctx& X, const bf16_t* P, bf16_t* OT, const float* t5) {
    TID_INIT();
    char* lds = (char*)X.lds; float* bias_l = (float*)(lds + att2::OFF_BIAS);
    { const int h = tid >> 7, d = tid & 127; int b = d; if (d >= 16) { b = 16 + (int)(logf((float)d * (1.0f / 16.0f)) / logf(8.0f) * 16.0f); if (b > 31) b = 31; }
      bias_l[h * 128 + d] = (t5[b * 4 + h] - t5[31 * 4 + h]) * (1.0f / att::SCALE); }
    __syncthreads();
    for (int L = X.c; L < 512; L += X.G) {
        { const att2::Blk b1 = diff_blk(P, OT, bias_l, L, 1); att2::attn_block(b1, lds, X.lds, X.wv); }
        { const att2::Blk b0 = diff_blk(P, OT, bias_l, L, 0); att2::attn_block(b0, lds, X.lds, X.wv); }
    }
}
__device__ __forceinline__ att::BlockRef xattn_ref(const bf16_t* QX, const bf16_t* KVX, bf16_t* OX, int l, int L) {
    const int h = L & 3, qb = L >> 2; att::BlockRef r;
    r.Q = QX + (size_t)qb * 256 * 512 + h * 128; r.K = KVX + l * 1024 + h * 128; r.V = KVX + l * 1024 + 512 + h * 128; r.O = OX + (size_t)qb * 256 * 512 + h * 128; r.P0 = 1 << 20; r.btab = nullptr; return r;
}
__device__ __forceinline__ void phase_xattn(const Ctx& X, const bf16_t* QX, const bf16_t* KVX, bf16_t* OX, int l) {
    char* lds = (char*)X.lds; typedef att::Pitch<512, 2048, 512> PT;
    int L = X.c; if (L >= 256) return;
    att::BlockRef cur = xattn_ref(QX, KVX, OX, l, L); att::Seam Sm;
    att::attn_prime<PT>(cur, att::WBIG, lds, Sm, X.wv);
    for (;;) {
        const bool last = L + X.G >= 256; const int Ln = last ? L : L + X.G;
        const att::BlockRef nxt = last ? cur : xattn_ref(QX, KVX, OX, l, Ln);
        att::attn_block<false, PT>(cur, nxt, MEM_LEN, att::WBIG, lds, Sm, X.wv);
        if (last) break;
        cur = nxt; L = Ln;
    }
}

constexpr int PH_PER_LAYER = 15, N_PHASES = 1 + DEPTH * PH_PER_LAYER;
#define PHB const Params& p = p_kernarg; unsigned char* const ws = p.ws; Ctx X; X.G = gridDim.x; X.c = blockIdx.x; X.wv = wv; X.dry = 0; X.lds = smem; X.ws = ws; \
    bf16_t* const P = (bf16_t*)(ws + WS_P); bf16_t* const H = (bf16_t*)(ws + WS_H); bf16_t* const Y = (bf16_t*)(ws + WS_Y); bf16_t* const Y3 = (bf16_t*)(ws + WS_Y3); \
    bf16_t* const OT = (bf16_t*)(ws + WS_OT); bf16_t* const MG = (bf16_t*)(ws + WS_MG); bf16_t* const QX = (bf16_t*)(ws + WS_QX); bf16_t* const OX = (bf16_t*)(ws + WS_OX); \
    bf16_t* const YS = (bf16_t*)(ws + WS_YS); bf16_t* const YP = (bf16_t*)(ws + WS_P + 256 * MiB); (void)YP; float* const KVS = (float*)(ws + WS_KVS); bf16_t* const PRV = (bf16_t*)(ws + WS_PRV); \
    bf16_t* const KVX = (bf16_t*)(ws + WS_KVX); const float* const ROPE = (const float*)(ws + WS_ROPE); \
    RouteRec* const RR = (RouteRec*)(ws + WS_ROUTE); int* const SLOTTOK = (int*)(ws + WS_SLOTTOK); int* const HIST = (int*)(ws + WS_HIST); int* const TSTART = HIST + 4096; \
    (void)P; (void)H; (void)Y; (void)Y3; (void)OT; (void)MG; (void)QX; (void)OX; (void)YS; (void)KVS; (void)PRV; (void)KVX; (void)ROPE; (void)RR; (void)SLOTTOK; (void)HIST; (void)TSTART; (void)X
#if ONE_LAUNCH
#define IN0 true
#define IN(j) true
#ifndef PROBE_BAR
#define PROBE_BAR 1
#endif
#define SEAM() do { XcdBarrier bar_; bar_.bar = (unsigned*)(p_kernarg.ws + WS_CTL); bar_.x = xb_xcc_id(); bar_.st = ctl_l; bar_.wv = wv; for (int rb_ = 0; rb_ < PROBE_BAR; ++rb_) xcd_barrier(bar_); } while (0)
#else
#define IN0 (slot == 15)
#define IN(j) (slot == (j))
#define SEAM() do { } while (0)
#endif
#ifndef PROBE_MASK
#define PROBE_MASK 0x0
#endif
#ifndef PROBE_LAYER
#define PROBE_LAYER -1
#endif
#ifndef PROBE_NORM
#define PROBE_NORM 0x0
#endif
#define NPROBE(j) ((((PROBE_NORM) >> (j)) & 1) && (PROBE_LAYER < 0 || PROBE_LAYER == l))
#define XDUMMY ((float*)(ws + WS_Y3))
#ifndef PROBE_REPS
#define PROBE_REPS 2
#endif
#define REP(j) for (int rep_ = 0; rep_ < (((((PROBE_MASK) >> (j)) & 1) && (PROBE_LAYER < 0 || PROBE_LAYER == l)) ? PROBE_REPS : 1); ++rep_)
__device__ __forceinline__ void layer_body(const int l, const int slot, const Params& p_kernarg, LAS unsigned char* smem, volatile LAS unsigned* ctl_l, const int wv) {
    (void)slot; (void)ctl_l;
        REP(0) if (IN(0)) { PHB;
            { pg8::Gemm g{H, (const bf16_t*)(ws + WS_WIN) + (size_t)l * NIN16 * DM, S, NIN16, DM, 0, 0}; pg8::StaticOrder So; So.init(S, NIN16, X.G, X.c);
              pg8::EpiStore<1> E{P, NIN, 1.0f}; pg8::gemm_phase(X.lds, g, So, E, X.wv); }
            { pg8::Gemm g{(const bf16_t*)(ws + WS_H8), (const bf16_t*)(ws + WS_WIN8 + (size_t)l * NIN8 * DM), S, NIN8, DM / 2, 0, 0}; pg8::StaticOrder So; So.init(S, NIN8, X.G, X.c);
              pg8::EpiStore<2> E{P, NIN, 1.0f / WSC8}; pg8::gemm_phase<pg8::EpiStore<2>, pg8::StaticOrder, true>(X.lds, g, So, E, X.wv); }
        }
        SEAM();
        REP(1) if (IN(1)) { PHB;
            phase_ret_kv(X, P, ROPE, KVS);
            phase_conv(X, P, p.w_conv + l * 3 * 1024, Y3);
            __syncthreads();
            phase_diff_attn(X, P, OT, p.t5);
        }
        SEAM();
        REP(2) if (IN(2)) { PHB;
            phase_ret_scan(X, KVS, PRV);
            phase_diff_combine(X, OT, p.dlam + l * 512, p.dsub + l * 256, 0.8f - 0.6f * __expf(-0.3f * (float)l), Y3);
        }
        SEAM();
        REP(3) if (IN(3)) { PHB; phase_ret_out(X, P, ROPE, PRV, Y3); }
        SEAM();
        REP(4) if (IN(4)) { PHB;
            pg8::Gemm g{Y3, (const bf16_t*)(ws + WS_WBR) + (size_t)l * 3 * DM * 1024, S, DM, 1024, (size_t)DM * 1024 * 2, (size_t)S * 1024 * 2}; pg8::MergeOrder So; So.init(S, DM, X.G, X.c);
            pg8::EpiMerge E{MG, DM, P, NIN}; pg8::gemm_phase(X.lds, g, So, E, X.wv);
        }
        SEAM();
        REP(5) if (IN(5)) { PHB;
            pg8::Gemm g{MG, (const bf16_t*)(ws + WS_WMIX) + (size_t)l * DM * DM, S, DM, DM, 0, 0}; pg8::StaticOrder So; So.init(S, DM, X.G, X.c);
            pg8::EpiStore<0> E{Y, DM, 1.0f}; pg8::gemm_phase(X.lds, g, So, E, X.wv);
        }
        SEAM();
        REP(6) if (IN(6)) { PHB; if (NPROBE(6)) { if (l == 0) phase_norm<0, false, false, false, true>(X, p.x, XDUMMY, Y, p.g_post_mix + l * DM, H, nullptr, nullptr, nullptr, nullptr);
                else phase_norm<0, false, false, true, true>(X, p.out, XDUMMY, Y, p.g_post_mix + l * DM, H, nullptr, nullptr, nullptr, nullptr); __syncthreads(); }
            if (l == 0) phase_norm<0, false, false, false, true>(X, p.x, p.out, Y, p.g_post_mix + l * DM, H, nullptr, nullptr, nullptr, nullptr);
            else phase_norm<0, false, false, true, true>(X, p.out, p.out, Y, p.g_post_mix + l * DM, H, nullptr, nullptr, nullptr, nullptr); }
        SEAM();
        REP(7) if (IN(7)) { PHB;
            if (cvt_deferred(X.G) && X.c >= (l == 0 ? 136 : 128)) { Ctx X2 = X; X2.G = X.G - (l == 0 ? 136 : 128); X2.c = X.c - (l == 0 ? 136 : 128); const int e = NEXP - 1 - l;
                cvt_gateup8(X2, p.w_eg + (size_t)e * DM * DFF, p.w_eu + (size_t)e * DM * DFF, ws + WS_WEGU + (size_t)e * 14336 * DM, p.g_pre_ffn + DM, WSC8, 0); }
            else if (l == 0 && X.c >= 128) { pg8::Gemm g{(const bf16_t*)(ws + WS_MEMN), (const bf16_t*)(ws + WS_WXKV), MEM_LEN, 2048, DM, 0, 0}; pg8::StaticOrder So; So.init(MEM_LEN, 2048, X.G, X.c - 128);
                pg8::EpiStore<0> E{KVX, 2048, 1.0f}; pg8::gemm_phase(X.lds, g, So, E, X.wv); }
            else {
            pg8::Gemm g{H, (const bf16_t*)(ws + WS_WXQ) + (size_t)l * 512 * DM, S, 512, DM, 0, 0}; pg8::StaticOrder So; So.init(S, 512, X.G, X.c);
            pg8::EpiStore<0> E{QX, 512, 1.0f}; pg8::gemm_phase(X.lds, g, So, E, X.wv); }
        }
        SEAM();
        REP(8) if (IN(8)) { PHB; phase_xattn(X, QX, KVX, OX, l); }
        SEAM();
        REP(9) if (IN(9)) { PHB;
            pg8::Gemm g{OX, (const bf16_t*)(ws + WS_WXO) + (size_t)l * DM * 512, S, DM, 512, 0, 0}; pg8::StaticOrder So; So.init(S, DM, X.G, X.c);
            pg8::EpiStore<0> E{Y, DM, 1.0f}; pg8::gemm_phase(X.lds, g, So, E, X.wv);
        }
        SEAM();
        REP(10) if (IN(10)) { PHB;
            if (NPROBE(10)) { if (l == 0) phase_norm<0, false, false, true, true>(X, p.out, XDUMMY, Y, p.g_post_x + l * DM, FFN_GU_FP8 ? nullptr : H, nullptr, nullptr, nullptr, nullptr, FFN_GU_FP8 ? ws + WS_H8 : nullptr);
                else phase_norm<0, true, false, true, true>(X, p.out, XDUMMY, Y, p.g_post_x + l * DM, H, p.w_router, p.g_pre_ffn + DM, RR, HIST); __syncthreads(); }
            if (l == 0) phase_norm<0, false, false, true, true>(X, p.out, p.out, Y, p.g_post_x + l * DM, FFN_GU_FP8 ? nullptr : H, nullptr, nullptr, nullptr, nullptr, FFN_GU_FP8 ? ws + WS_H8 : nullptr);
            else phase_norm<0, true, false, true, true>(X, p.out, p.out, Y, p.g_post_x + l * DM, H, p.w_router, p.g_pre_ffn + DM, RR, HIST);
        }
        SEAM();
        if (l == 0) {
            REP(11) if (IN(11)) { PHB;
                pg8::StaticOrder So; So.init(S, 2 * DFF, X.G, X.c);
                if (FFN_GU_FP8) { pg8::Gemm g{(const bf16_t*)(ws + WS_H8), (const bf16_t*)(ws + WS_WGU), S, 2 * DFF, DM / 2, 0, 0};
                    pg8::EpiSwiglu8 E{(unsigned char*)P, DFF, 1.0f / WSC8}; pg8::gemm_phase<pg8::EpiSwiglu8, pg8::StaticOrder, true>(X.lds, g, So, E, X.wv); }
                else { pg8::Gemm g{H, (const bf16_t*)(ws + WS_WGU), S, 2 * DFF, DM, 0, 0};
                    pg8::EpiSwiglu8 E{(unsigned char*)P, DFF, 1.0f}; pg8::gemm_phase(X.lds, g, So, E, X.wv); }
            }
            SEAM();
            REP(12) if (IN(12)) { PHB;
                pg8::Gemm g{P, (const bf16_t*)(ws + WS_WDN), S, DM, DFF / 2, 0, 0}; pg8::StaticOrder So; So.init(S, DM, X.G, X.c);
                pg8::EpiStore<0> E{Y, DM, 1.0f / WSC8}; pg8::gemm_phase<pg8::EpiStore<0>, pg8::StaticOrder, true>(X.lds, g, So, E, X.wv);
            }
            SEAM();
            REP(13) if (IN(13)) { PHB; if (NPROBE(13)) { phase_norm<0, false, false, true, true>(X, p.out, XDUMMY, Y, p.g_post_ffn + l * DM, H, nullptr, nullptr, nullptr, nullptr, ws + WS_H8); __syncthreads(); }
                phase_norm<0, false, false, true, true>(X, p.out, p.out, Y, p.g_post_ffn + l * DM, H, nullptr, nullptr, nullptr, nullptr, ws + WS_H8); }
            SEAM();
        } else {
            REP(11) if (IN(11)) { PHB; phase_assign(X, RR, HIST, TSTART, SLOTTOK, (const unsigned char*)H, (unsigned char*)Y3); }
            SEAM();
            REP(12) if (IN(12)) { PHB;
                pg8::Gemm g{Y3, (const bf16_t*)(ws + WS_WEGU), 0, 2 * DFF, DM / 2, (size_t)14336 * DM, 0}; pg8::MoeOrder<false> So; So.init(TSTART, 2 * DFF, X.G, X.c, nullptr);
                pg8::EpiSwiglu8 E{(unsigned char*)P, DFF, 1.0f / WSC8}; pg8::gemm_phase<pg8::EpiSwiglu8, pg8::MoeOrder<false>, true>(X.lds, g, So, E, X.wv);
            }
            SEAM();
            REP(13) if (IN(13)) { PHB;
                const int T = moe_tail_units(TSTART, X.G);
                { pg8::Gemm g{P, (const bf16_t*)(ws + WS_WEDN), 0, DM, DFF / 2, (size_t)DM * DFF, 0}; pg8::MoeOrder<false> So; So.init(TSTART, DM, X.G, X.c, nullptr); So.lim = So.nwg - T;
                  pg8::EpiStore<0> E{YS, DM, 1.0f / WSC8}; pg8::gemm_phase<pg8::EpiStore<0>, pg8::MoeOrder<false>, true>(X.lds, g, So, E, X.wv); }
                if (T > 0) { pg8::Gemm g{P, (const bf16_t*)(ws + WS_WEDN), 0, DM, pg8::MoeTailOrder::SLB / 2, (size_t)DM * DFF, 0, DFF / 2}; pg8::MoeTailOrder So; So.init(TSTART, DM, X.G, X.c, TSTART[8] * (DM / 256) - T, T);
                  pg8::EpiPart E{YP, 1.0f / WSC8}; pg8::gemm_phase<pg8::EpiPart, pg8::MoeTailOrder, true>(X.lds, g, So, E, X.wv); }
            }
            SEAM();
            REP(15) if (IN(15)) { PHB; phase_tailfix(X, TSTART, YP, YS); }
            SEAM();
            REP(14) if (IN(14)) { PHB; if (NPROBE(14)) { phase_norm<1, false, true, true, false>(X, p.out, XDUMMY, YS, p.g_post_ffn + l * DM, nullptr, nullptr, nullptr, RR, nullptr); __syncthreads(); }
                phase_norm<1, false, true, true, false>(X, p.out, p.out, YS, p.g_post_ffn + l * DM, nullptr, nullptr, nullptr, RR, nullptr); }
        }
}
__global__ void __launch_bounds__(512, 2) trunk_fwd(Params p_kernarg) {
    extern __shared__ __attribute__((aligned(16))) unsigned char smem_raw[];
    LAS unsigned char* const smem = (LAS unsigned char*)smem_raw;
    volatile LAS unsigned* ctl_l = (volatile LAS unsigned*)(smem + LDS_CTL_OFF);
    if (threadIdx.x < 32) ctl_l[threadIdx.x] = 0u;
    const int wv = __builtin_amdgcn_readfirstlane(threadIdx.x >> 6);
    __syncthreads();
#if ONE_LAUNCH
    (void)xcd_barrier_post((unsigned*)(p_kernarg.ws + WS_CTL), ctl_l);
    const int slot = 0;
#else
    const int slot = p_kernarg.ph_hi, lsel = p_kernarg.ph_lo;
#endif
    for (int rep_ = 0; rep_ < ((((PROBE_MASK) >> 15) & 1) ? PROBE_REPS : 1); ++rep_) if (IN0) { PHB; phase_prologue(X, p); }
#if PROBE_CVT
    { PHB; X.dry = PROBE_CVT; phase_prologue(X, p); }
#endif
    SEAM();
#if ONE_LAUNCH
    layer_body(0, slot, p_kernarg, smem, ctl_l, wv);
    layer_body(1, slot, p_kernarg, smem, ctl_l, wv);
#else
    layer_body(lsel, slot, p_kernarg, smem, ctl_l, wv);
#endif
}
#undef IN
#undef IN0
#undef SEAM
#undef PHB

extern "C" void kernel_launch(void* const* d_in, const int* in_sizes, int n_in, void* d_out, int out_size, void* d_ws, size_t ws_size, hipStream_t stream) {
    static int grid = 0;
    if (grid == 0) {
        if (n_in != 26 || out_size != S * DM || ws_size < WS_END) { fprintf(stderr, "kernel_launch: unexpected shapes (n_in %d out %d ws %zu)\n", n_in, out_size, ws_size); grid = -1; return; }
        int dev = 0, cus = 0, per_cu = 0;
        if (hipGetDevice(&dev) != hipSuccess || hipDeviceGetAttribute(&cus, hipDeviceAttributeMultiprocessorCount, dev) != hipSuccess) { grid = -1; return; }
        if (hipFuncSetAttribute((const void*)trunk_fwd, hipFuncAttributeMaxDynamicSharedMemorySize, LDS_BYTES) != hipSuccess) { fprintf(stderr, "kernel_launch: hipFuncSetAttribute failed\n"); grid = -1; return; }
        if (hipOccupancyMaxActiveBlocksPerMultiprocessor(&per_cu, (const void*)trunk_fwd, 512, LDS_BYTES) != hipSuccess || per_cu < 1) { fprintf(stderr, "kernel_launch: occupancy query says %d\n", per_cu); (void)hipGetLastError(); grid = -1; return; }
        grid = cus;
    }
    if (grid < 0) return;
    (void)hipMemsetAsync((char*)d_ws + WS_CTL, 0, CTL_ZERO_BYTES, stream);
    Params p{};
    const float** f = (const float**)&p;
    for (int i = 0; i < 26; ++i) f[i] = (const float*)d_in[i];
    p.out = (float*)d_out; p.ws = (unsigned char*)d_ws;
#if ONE_LAUNCH
    p.ph_lo = 0; p.ph_hi = 0;
    hipLaunchKernelGGL(trunk_fwd, dim3(grid), dim3(512), LDS_BYTES, stream, p);
#else
    p.ph_lo = 0; p.ph_hi = 15; hipLaunchKernelGGL(trunk_fwd, dim3(grid), dim3(512), LDS_BYTES, stream, p);
    for (int l = 0; l < DEPTH; ++l) for (int j = 0; j < 15; ++j) { if (l == 0 && j == 14) continue;
        p.ph_lo = l; p.ph_hi = j; hipLaunchKernelGGL(trunk_fwd, dim3(grid), dim3(512), LDS_BYTES, stream, p); }
#endif
}
```

```cpp
#include <hip/hip_runtime.h>
#include <cstdio>
#include <cstdint>

#ifndef ONE_LAUNCH
#define ONE_LAUNCH 1
#endif

#define LAS __attribute__((address_space(3)))
typedef unsigned short bf16_t;
typedef short bf16x8 __attribute__((ext_vector_type(8)));
typedef short s16x4 __attribute__((ext_vector_type(4)));
typedef float f32x4 __attribute__((ext_vector_type(4)));
typedef float f32x2 __attribute__((ext_vector_type(2)));
typedef float f32x16 __attribute__((ext_vector_type(16)));
typedef unsigned u32x4 __attribute__((ext_vector_type(4)));
typedef unsigned u32x2 __attribute__((ext_vector_type(2)));

constexpr int S = 16384, DM = 2048, DEPTH = 2, MEM_LEN = 256;
constexpr int NIN = 16384;
constexpr int NIN16 = 10240, NIN8 = NIN - NIN16;
constexpr int C_RQ = 0, C_RK = 1024, C_RV = 2048, C_RG = 3072, C_CB = 4096, C_CC = 5120, C_CU = 6144, C_DQ = 7168, C_DK = 8192, C_DV = 9216, C_GL = 10240;
constexpr int DFF = 7168, NEXP = 8;
constexpr float EPS = 1e-6f;
constexpr float WSC8 = 32.0f;
constexpr int MOE_MAXROWS = 2 * S + NEXP * 256;
__host__ __device__ __forceinline__ size_t pidx(int row, int col) { return ((size_t)(col >> 8) * S + (size_t)row) * 256 + (size_t)(col & 255); }

constexpr size_t MiB = 1u << 20;
constexpr size_t WS_CTL = 0, CTL_ZERO_BYTES = 64 * 1024;
constexpr size_t WS_KVX = 1 * MiB;
constexpr size_t WS_MEMN = 2 * MiB;
constexpr size_t WS_ROUTE = 3 * MiB;
constexpr size_t WS_SLOTTOK = 4 * MiB;
constexpr size_t WS_HIST = 5 * MiB;
constexpr size_t WS_ROPE = 6 * MiB;
constexpr size_t WS_W = 16 * MiB;
constexpr size_t WS_WIN = WS_W;
constexpr size_t WS_WIN8 = WS_WIN + 80 * MiB;
constexpr size_t WS_WBR = WS_WIN + 128 * MiB;
constexpr size_t WS_WMIX = WS_WBR + 24 * MiB;
constexpr size_t WS_WXQ = WS_WMIX + 16 * MiB;
constexpr size_t WS_WXKV = WS_WXQ + 4 * MiB;
constexpr size_t WS_WXO = WS_WXKV + 8 * MiB;
constexpr size_t WS_WGU = WS_WXO + 4 * MiB;
constexpr size_t WS_WDN = WS_WGU + 56 * MiB;
constexpr size_t WS_WEGU = WS_WDN + 28 * MiB;
constexpr size_t WS_WEDN = WS_WEGU + 224 * MiB;
constexpr size_t WS_P = WS_WEDN + 112 * MiB;
constexpr size_t WS_H = WS_P + 512 * MiB;
constexpr size_t WS_Y = WS_H + 64 * MiB;
constexpr size_t WS_Y3 = WS_Y + 64 * MiB;
constexpr size_t WS_OT = WS_Y3 + 96 * MiB;
constexpr size_t WS_MG = WS_OT + 64 * MiB;
constexpr size_t WS_QX = WS_MG, WS_OX = WS_MG + 16 * MiB;
constexpr size_t WS_YS = WS_MG + 64 * MiB;
constexpr size_t WS_KVS = WS_YS, WS_PRV = WS_YS + 64 * MiB;
constexpr size_t WS_H8 = WS_YS + 136 * MiB;
constexpr size_t WS_END = WS_H8 + 32 * MiB;
static_assert(WS_END <= (size_t)2010 * MiB, "workspace map exceeds the guaranteed size");

constexpr int LDS_BYTES = 163840;
constexpr int LDS_CTL_OFF = 163328;

__device__ __forceinline__ float bf2f(unsigned b) { return __uint_as_float(b << 16); }
__device__ __forceinline__ unsigned f2bf(float f) { unsigned u = __float_as_uint(f); return (u + 0x7fffu + ((u >> 16) & 1u)) >> 16; }
__device__ __forceinline__ unsigned pk2(float lo, float hi) { return f2bf(lo) | (f2bf(hi) << 16); }
__device__ __forceinline__ unsigned cvt_pk_bf16(float lo, float hi) { unsigned r; asm volatile("v_cvt_pk_bf16_f32 %0, %1, %2" : "=v"(r) : "v"(lo), "v"(hi)); return r; }
__device__ __forceinline__ float wave_sum(float v) {
    v += __int_as_float(__builtin_amdgcn_ds_swizzle(__float_as_int(v), 0x041F));
    v += __int_as_float(__builtin_amdgcn_ds_swizzle(__float_as_int(v), 0x081F));
    v += __int_as_float(__builtin_amdgcn_ds_swizzle(__float_as_int(v), 0x101F));
    v += __int_as_float(__builtin_amdgcn_ds_swizzle(__float_as_int(v), 0x201F));
    v += __int_as_float(__builtin_amdgcn_ds_swizzle(__float_as_int(v), 0x401F));
    const auto rr = __builtin_amdgcn_permlane32_swap(__float_as_uint(v), __float_as_uint(v), false, false);
    return __uint_as_float(rr[0]) + __uint_as_float(rr[1]);
}
__device__ __forceinline__ float fast_sigmoid(float x) { return __builtin_amdgcn_rcpf(1.0f + __builtin_amdgcn_exp2f(-1.4426950408889634f * x)); }
__device__ __forceinline__ float clamp8(float v) { return __builtin_fminf(__builtin_fmaxf(v, -448.0f), 448.0f); }
__device__ __forceinline__ unsigned pk4_fp8(float a, float b, float c, float d) { int v = 0; v = __builtin_amdgcn_cvt_pk_fp8_f32(clamp8(a), clamp8(b), v, false); v = __builtin_amdgcn_cvt_pk_fp8_f32(clamp8(c), clamp8(d), v, true); return (unsigned)v; }
__device__ __forceinline__ int lane_id_opaque() { int l = (int)__builtin_amdgcn_mbcnt_hi(~0u, __builtin_amdgcn_mbcnt_lo(~0u, 0u)); asm volatile("" : "+v"(l)); return l; }
#define LDS_WAIT() asm volatile("s_waitcnt lgkmcnt(0)" ::: "memory")
#define VM_WAIT() asm volatile("s_waitcnt vmcnt(0)" ::: "memory")

namespace pg8 {
constexpr bool PG8_SP2 = true;
constexpr int BM = 256, BK = 64, HALF = 128, HTB = HALF * BK * 2, STAGE_BYTES = 8 * HTB, NXCD = 8, WGM = 8;
__host__ __device__ __forceinline__ int lds_byte(int r, int c) { const int st = (r >> 4) * 2 + (c >> 5), rr = r & 15, cc = c & 31, ob = rr * 64 + cc * 2; return st * 1024 + (ob ^ (((ob >> 9) & 1) << 5)); }
__host__ __device__ __forceinline__ void stage_rc(int b, int& R, int& C) { const int st = b / 1024, sb = b % 1024, swz = sb ^ (((sb >> 9) & 1) << 5); R = (st >> 1) * 16 + swz / 64; C = (st & 1) * 32 + (swz % 64) / 2; }
__host__ __device__ __forceinline__ int perm32(int rho) { const int n = rho >> 4, i = rho & 15; return 8 * (i >> 2) + 4 * n + (i & 3); }

struct Unit { int pm, pn, e, ko, aux; };
struct Gemm { const bf16_t* A; const bf16_t* Bt; int M, N, K; size_t bstride, astride; int ld = 0; };

struct StaticOrder {
    static constexpr bool GATHER = false;
    int nM, nN, nwg, G, c;
    __device__ __forceinline__ void init(int M, int N, int G_, int c_) { nM = M / BM; nN = N / BM; nwg = nM * nN; G = G_; c = c_; }
    __device__ __forceinline__ bool next(int i, Unit& u) const {
        const long L = (long)i * G + c; if (L >= nwg) return false;
        int wgid = (int)L; { const int q = nwg / NXCD, r = nwg % NXCD, xcd = wgid % NXCD, off = wgid / NXCD; wgid = (xcd < r ? xcd * (q + 1) : r * (q + 1) + (xcd - r) * q) + off; }
        const int nig = WGM * nN, gid = wgid / nig, fm = gid * WGM, gsz = (nM - fm) < WGM ? (nM - fm) : WGM;
        u.pm = fm + ((wgid % nig) % gsz); u.pn = (wgid % nig) / gsz; u.e = 0; u.ko = 0; u.aux = 0; return true;
    }
    __device__ __forceinline__ int tok(int) const { return 0; }
};
template <bool GATH> struct MoeOrder {
    static constexpr bool GATHER = GATH;
    int nM, nN, nwg, G, c, lim; int ts1, ts2, ts3, ts4, ts5, ts6, ts7; const int* tokp;
    __device__ __forceinline__ void init(const int* tstart, int N, int G_, int c_, const int* tokp_) {
        nM = tstart[8]; nN = N / BM; nwg = nM * nN; lim = nwg; G = G_; c = c_; tokp = tokp_;
        ts1 = tstart[1]; ts2 = tstart[2]; ts3 = tstart[3]; ts4 = tstart[4]; ts5 = tstart[5]; ts6 = tstart[6]; ts7 = tstart[7];
    }
    __device__ __forceinline__ void unit_of(int L, Unit& u) const {
        int wgid = L; { const int q = nwg / NXCD, r = nwg % NXCD, xcd = wgid % NXCD, off = wgid / NXCD; wgid = (xcd < r ? xcd * (q + 1) : r * (q + 1) + (xcd - r) * q) + off; }
        const int nig = WGM * nN, gid = wgid / nig, fm = gid * WGM, gsz = (nM - fm) < WGM ? (nM - fm) : WGM;
        u.pm = fm + ((wgid % nig) % gsz); u.pn = (wgid % nig) / gsz; u.ko = 0; u.aux = 0;
        u.e = (u.pm >= ts1) + (u.pm >= ts2) + (u.pm >= ts3) + (u.pm >= ts4) + (u.pm >= ts5) + (u.pm >= ts6) + (u.pm >= ts7);
    }
    __device__ __forceinline__ bool next(int i, Unit& u) const {
        const long L = (long)i * G + c; if (L >= lim) return false;
        unit_of((int)L, u); return true;
    }
    __device__ __forceinline__ int tok(int row) const { return tokp[row]; }
};

template <int MODE> struct EpiStore {
    static constexpr bool MID = false;
    bf16_t* O; int ldc; float scale;
    __device__ __forceinline__ bool operator()(f32x4 (&acc)[2][2][4][2], const Unit& u, int wr, int wc, int fr, int fq) const {
        const int row0 = u.pm * BM + wr * 64 + fr, col0 = u.pn * BM + wc * 32 + 8 * fq;
        const int act = (MODE == 1) ? ((u.pn >= 12 && u.pn < 16) ? 1 : (u.pn >= 40 ? 2 : 0)) : (MODE == 2 ? 2 : 0);
        const int ptile = (MODE == 2) ? u.pn + 40 : u.pn;
#pragma unroll
        for (int ai = 0; ai < 2; ++ai)
#pragma unroll
            for (int m = 0; m < 4; ++m) { bf16_t* rowp = (MODE != 0) ? O + ((size_t)ptile * S + (size_t)(row0 + ai * HALF + m * 16)) * 256 + (wc * 32 + 8 * fq) : O + (size_t)(row0 + ai * HALF + m * 16) * ldc + col0;
#pragma unroll
                for (int bj = 0; bj < 2; ++bj) { f32x4 v0 = acc[ai][bj][m][0] * scale, v1 = acc[ai][bj][m][1] * scale;
                    if (MODE != 0 && act != 0) {
#pragma unroll
                        for (int j = 0; j < 4; ++j) { const float s0 = fast_sigmoid(v0[j]), s1 = fast_sigmoid(v1[j]);
                            v0[j] = (act == 1) ? v0[j] * s0 : fmaxf(s0, 1e-6f); v1[j] = (act == 1) ? v1[j] * s1 : fmaxf(s1, 1e-6f); } }
                    u32x4 w; w.x = cvt_pk_bf16(v0[0], v0[1]); w.y = cvt_pk_bf16(v0[2], v0[3]); w.z = cvt_pk_bf16(v1[0], v1[1]); w.w = cvt_pk_bf16(v1[2], v1[3]);
                    *(u32x4*)(rowp + bj * HALF) = w; } }
        return false;
    }
};
struct EpiSwiglu {
    static constexpr bool MID = false;
    bf16_t* O; int ldc;
    __device__ __forceinline__ bool operator()(f32x4 (&acc)[2][2][4][2], const Unit& u, int wr, int wc, int fr, int fq) const {
        const int row0 = u.pm * BM + wr * 64 + fr, col0 = u.pn * HALF + wc * 32 + 8 * fq;
#pragma unroll
        for (int ai = 0; ai < 2; ++ai)
#pragma unroll
            for (int m = 0; m < 4; ++m) { bf16_t* rowp = O + (size_t)(row0 + ai * HALF + m * 16) * ldc + col0;
                f32x4 v0, v1;
#pragma unroll
                for (int j = 0; j < 4; ++j) { const float g0 = acc[ai][0][m][0][j], g1 = acc[ai][0][m][1][j];
                    v0[j] = g0 * fast_sigmoid(g0) * acc[ai][1][m][0][j]; v1[j] = g1 * fast_sigmoid(g1) * acc[ai][1][m][1][j]; }
                u32x4 w; w.x = cvt_pk_bf16(v0[0], v0[1]); w.y = cvt_pk_bf16(v0[2], v0[3]); w.z = cvt_pk_bf16(v1[0], v1[1]); w.w = cvt_pk_bf16(v1[2], v1[3]);
                *(u32x4*)rowp = w; }
        return false;
    }
};
struct EpiMerge {
    static constexpr bool MID = false;
    bf16_t* O; int ldc; const bf16_t* G; int ldg;
    __device__ __forceinline__ void unp(const u32x4 w, float (&g)[8]) const {
        g[0] = bf2f(w.x & 0xffffu); g[1] = bf2f(w.x >> 16); g[2] = bf2f(w.y & 0xffffu); g[3] = bf2f(w.y >> 16);
        g[4] = bf2f(w.z & 0xffffu); g[5] = bf2f(w.z >> 16); g[6] = bf2f(w.w & 0xffffu); g[7] = bf2f(w.w >> 16);
    }
    __device__ __forceinline__ bool operator()(f32x4 (&acc)[2][2][4][2], const Unit& u, int wr, int wc, int fr, int fq) const {
        const int row0 = u.pm * BM + wr * 64 + fr, col0 = u.pn * BM + wc * 32 + 8 * fq;
        if (u.e < 2) {
#pragma unroll
            for (int ai = 0; ai < 2; ++ai) { u32x4 ga[4][2], gb[4][2];
#pragma unroll
                for (int m = 0; m < 4; ++m) { const bf16_t* gp = G + ((size_t)(40 + u.e * 8 + u.pn) * S + (size_t)(row0 + ai * HALF + m * 16)) * 256 + (wc * 32 + 8 * fq);
#pragma unroll
                    for (int bj = 0; bj < 2; ++bj) { ga[m][bj] = *(const u32x4*)(gp + bj * HALF); gb[m][bj] = *(const u32x4*)(gp + bj * HALF + (size_t)8 * S * 256); } }
                asm volatile("" ::: "memory");
#pragma unroll
                for (int m = 0; m < 4; ++m)
#pragma unroll
                    for (int bj = 0; bj < 2; ++bj) { float a[8], b[8]; unp(ga[m][bj], a); unp(gb[m][bj], b);
#pragma unroll
                        for (int j = 0; j < 4; ++j) { acc[ai][bj][m][0][j] *= a[j] * __builtin_amdgcn_rcpf(b[j]); acc[ai][bj][m][1][j] *= a[4 + j] * __builtin_amdgcn_rcpf(b[4 + j]); } }
                asm volatile("" : "+v"(acc[ai][0][0][0]), "+v"(acc[ai][1][0][0]) :: "memory"); }
            return true;
        }
#pragma unroll
        for (int ai = 0; ai < 2; ++ai) { u32x4 gc[4][2];
#pragma unroll
            for (int m = 0; m < 4; ++m) { const bf16_t* gp = G + ((size_t)(40 + 16 + u.pn) * S + (size_t)(row0 + ai * HALF + m * 16)) * 256 + (wc * 32 + 8 * fq);
#pragma unroll
                for (int bj = 0; bj < 2; ++bj) gc[m][bj] = *(const u32x4*)(gp + bj * HALF); }
            asm volatile("" ::: "memory");
#pragma unroll
            for (int m = 0; m < 4; ++m) { bf16_t* rowp = O + (size_t)(row0 + ai * HALF + m * 16) * ldc + col0;
#pragma unroll
                for (int bj = 0; bj < 2; ++bj) { float c[8]; unp(gc[m][bj], c); const f32x4 v0 = acc[ai][bj][m][0], v1 = acc[ai][bj][m][1];
                    u32x4 w; w.x = cvt_pk_bf16(v0[0] * c[0], v0[1] * c[1]); w.y = cvt_pk_bf16(v0[2] * c[2], v0[3] * c[3]); w.z = cvt_pk_bf16(v1[0] * c[4], v1[1] * c[5]); w.w = cvt_pk_bf16(v1[2] * c[6], v1[3] * c[7]);
                    *(u32x4*)(rowp + bj * HALF) = w; } }
            asm volatile("" ::: "memory"); }
        return false;
    }
};
struct EpiSwiglu8 {
    static constexpr bool MID = false;
    unsigned char* O; int ldc; float scale;
    __device__ __forceinline__ bool operator()(f32x4 (&acc)[2][2][4][2], const Unit& u, int wr, int wc, int fr, int fq) const {
        const int row0 = u.pm * BM + wr * 64 + fr, col0 = u.pn * HALF + wc * 32 + 8 * fq;
        const float c1 = -1.4426950408889634f * scale, s2 = scale * scale;
#pragma unroll
        for (int ai = 0; ai < 2; ++ai)
#pragma unroll
            for (int m = 0; m < 4; ++m) { unsigned char* rowp = O + (size_t)(row0 + ai * HALF + m * 16) * ldc + col0;
                f32x4 e0, e1, v0, v1;
#pragma unroll
                for (int j = 0; j < 4; ++j) { e0[j] = __builtin_amdgcn_exp2f(acc[ai][0][m][0][j] * c1); e1[j] = __builtin_amdgcn_exp2f(acc[ai][0][m][1][j] * c1); }
                __builtin_amdgcn_sched_barrier(0);
#pragma unroll
                for (int j = 0; j < 4; ++j) { v0[j] = acc[ai][0][m][0][j] * acc[ai][1][m][0][j]; v1[j] = acc[ai][0][m][1][j] * acc[ai][1][m][1][j]; e0[j] = 1.0f + e0[j]; e1[j] = 1.0f + e1[j]; }
                __builtin_amdgcn_sched_barrier(0);
#pragma unroll
                for (int j = 0; j < 4; ++j) { e0[j] = __builtin_amdgcn_rcpf(e0[j]); e1[j] = __builtin_amdgcn_rcpf(e1[j]); }
                __builtin_amdgcn_sched_barrier(0);
#pragma unroll
                for (int j = 0; j < 4; ++j) { v0[j] = v0[j] * s2; v1[j] = v1[j] * s2; }
#pragma unroll
                for (int j = 0; j < 4; ++j) { v0[j] = v0[j] * e0[j]; v1[j] = v1[j] * e1[j]; }
                u32x2 w; w.x = pk4_fp8(v0[0], v0[1], v0[2], v0[3]); w.y = pk4_fp8(v1[0], v1[1], v1[2], v1[3]);
                *(u32x2*)rowp = w; }
        return false;
    }
};
struct MergeOrder {
    static constexpr bool GATHER = false;
    StaticOrder so;
    __device__ __forceinline__ void init(int M, int N, int G_, int c_) { so.init(M, N, G_, c_); }
    __device__ __forceinline__ bool next(int i, Unit& u) const { const int q = i / 3; if (!so.next(q, u)) return false; u.e = i - 3 * q; return true; }
    __device__ __forceinline__ int tok(int) const { return 0; }
};

struct MoeTailOrder {
    static constexpr bool GATHER = false;
    static constexpr int NSL = 7, SLB = 1024;
    MoeOrder<false> mo; int first, nsub;
    __device__ __forceinline__ void init(const int* tstart, int N, int G_, int c_, int first_, int T) { mo.init(tstart, N, G_, c_, nullptr); first = first_; nsub = T * NSL; }
    __device__ __forceinline__ bool next(int i, Unit& u) const { const int idx = i * mo.G + mo.c; if (idx >= nsub) return false;
        const int j = idx / NSL, ks = idx - j * NSL; mo.unit_of(first + j, u); u.ko = ks * SLB; u.aux = idx; return true; }
    __device__ __forceinline__ int tok(int) const { return 0; }
};
struct EpiPart {
    static constexpr bool MID = false;
    bf16_t* O; float scale;
    __device__ __forceinline__ bool operator()(f32x4 (&acc)[2][2][4][2], const Unit& u, int wr, int wc, int fr, int fq) const {
        bf16_t* base = O + ((size_t)u.aux << 16) + (size_t)(wr * 64 + fr) * 256 + wc * 32 + 8 * fq;
#pragma unroll
        for (int ai = 0; ai < 2; ++ai)
#pragma unroll
            for (int m = 0; m < 4; ++m) { bf16_t* rowp = base + (size_t)(ai * HALF + m * 16) * 256;
#pragma unroll
                for (int bj = 0; bj < 2; ++bj) { const f32x4 v0 = acc[ai][bj][m][0] * scale, v1 = acc[ai][bj][m][1] * scale;
                    u32x4 w; w.x = cvt_pk_bf16(v0[0], v0[1]); w.y = cvt_pk_bf16(v0[2], v0[3]); w.z = cvt_pk_bf16(v1[0], v1[1]); w.w = cvt_pk_bf16(v1[2], v1[3]);
                    *(u32x4*)(rowp + bj * HALF) = w; } }
        return false;
    }
};

template <class Epi, class Sched, bool FP8 = false>
__device__ __forceinline__ void gemm_phase(LAS unsigned char* lds, const Gemm g, const Sched& S, const Epi& E, const int wid) {
    const int lane = lane_id_opaque(), tid = (wid << 6) | lane;
    const int wr = wid >> 2, wc = wid & 3, fr = lane & 15, fq = lane >> 4;
    const int K = g.K, nt = K / BK, LD = g.ld ? g.ld : K;
    unsigned voffA[2], voffB[2];
#pragma unroll
    for (int i = 0; i < 2; ++i) { int R, C; stage_rc(tid * 16 + i * 8192, R, C); const int Rb = (R & ~31) + perm32(R & 31);
        voffA[i] = (unsigned)(R * LD + C) * 2u; voffB[i] = (unsigned)(Rb * LD + C) * 2u; }
    const size_t kstep = (size_t)(BK * 2);
    const size_t hstep = (size_t)HALF * LD * 2;
    const size_t tstep = 2 * hstep;
    const unsigned ldsw = (unsigned)wid * 1024u;
    const int aoff = lds_byte(wr * 64 + fr, fq * 8), boff = lds_byte(wc * 32 + fr, fq * 8);
#define PG8_SA(b, h) (((b) * 2 + (h)) * HTB)
#define PG8_SB(b, h) ((4 + (b) * 2 + (h)) * HTB)
#define PG8_STAGE(bufoff, gbase, voff) do { _Pragma("unroll") for (int _i = 0; _i < 2; ++_i) \
        __builtin_amdgcn_global_load_lds((const unsigned*)((const char*)(gbase) + (voff)[_i]), (LAS unsigned*)(lds + (bufoff) + ldsw + _i * 8192), 16, 0, 0); } while (0)
#define PG8_STAGE_A(bufoff, nx, h, kt) do { if constexpr (Sched::GATHER) { unsigned _o[2]; _o[0] = (nx) ? ngofs[h][0] : gofs[h][0]; _o[1] = (nx) ? ngofs[h][1] : gofs[h][1]; \
            PG8_STAGE(bufoff, (const char*)g.A + (size_t)(kt) * kstep, _o); } \
        else { PG8_STAGE(bufoff, ((nx) ? nA : cA) + (size_t)(h) * hstep + (size_t)(kt) * kstep, voffA); } } while (0)
#define PG8_LDA(dst, b, h) do { _Pragma("unroll") for (int m = 0; m < 4; ++m) _Pragma("unroll") for (int k = 0; k < 2; ++k) dst[m][k] = *(const LAS bf16x8*)(lds + PG8_SA(b, h) + aoff + m * 2048 + k * 1024); } while (0)
#define PG8_LDB(dst, b, h) do { _Pragma("unroll") for (int n = 0; n < 2; ++n) _Pragma("unroll") for (int k = 0; k < 2; ++k) dst[n][k] = *(const LAS bf16x8*)(lds + PG8_SB(b, h) + boff + n * 2048 + k * 1024); } while (0)
#define PG8_MMAP(ai, bj, At, Bt, P1, P0) do { if constexpr (!FP8 && (P1)) __builtin_amdgcn_s_setprio(1); _Pragma("unroll") for (int m = 0; m < 4; ++m) _Pragma("unroll") for (int n = 0; n < 2; ++n) { \
        if constexpr (FP8) { typedef int i32x8 __attribute__((ext_vector_type(8))); typedef int i32x4 __attribute__((ext_vector_type(4))); \
            const i32x4 b0_ = __builtin_bit_cast(i32x4, Bt[n][0]), b1_ = __builtin_bit_cast(i32x4, Bt[n][1]), a0_ = __builtin_bit_cast(i32x4, At[m][0]), a1_ = __builtin_bit_cast(i32x4, At[m][1]); \
            const i32x8 b8_ = {b0_[0], b0_[1], b0_[2], b0_[3], b1_[0], b1_[1], b1_[2], b1_[3]}, a8_ = {a0_[0], a0_[1], a0_[2], a0_[3], a1_[0], a1_[1], a1_[2], a1_[3]}; \
            asm volatile("v_mfma_f32_16x16x128_f8f6f4 %0, %1, %2, %0" : "+v"(acc[ai][bj][m][n]) : "v"(b8_), "v"(a8_)); } \
        else { _Pragma("unroll") for (int k = 0; k < 2; ++k) acc[ai][bj][m][n] = __builtin_amdgcn_mfma_f32_16x16x32_bf16(Bt[n][k], At[m][k], acc[ai][bj][m][n], 0, 0, 0); } } \
        if constexpr (!FP8 && (P0)) __builtin_amdgcn_s_setprio(0); } while (0)
#define PG8_MMA(ai, bj, At, Bt) PG8_MMAP(ai, bj, At, Bt, true, true)
#define PG8_WAIT_V(n) asm volatile("s_waitcnt vmcnt(" #n ")" ::: "memory")
#define PG8_WAIT_L(n) asm volatile("s_waitcnt lgkmcnt(" #n ")" ::: "memory")
#define PG8_BAR __builtin_amdgcn_s_barrier()
#define PG8_SCHED __builtin_amdgcn_sched_barrier(0)
#define PG8_GOFS(dst, u_) do { _Pragma("unroll") for (int _h = 0; _h < 2; ++_h) _Pragma("unroll") for (int _i = 0; _i < 2; ++_i) \
        { int _R, _C; stage_rc(tid * 16 + _i * 8192, _R, _C); dst[_h][_i] = (unsigned)(S.tok((u_).pm * BM + _h * HALF + _R) * K + _C) * 2u; } } while (0)
    int sc8 = 0x7F7F7F7F; asm volatile("" : "+v"(sc8)); (void)sc8;
    Unit cur, nxt; int ui = 0;
    if (!S.next(0, cur)) return;
    f32x4 acc[2][2][4][2];
#pragma unroll
    for (int a = 0; a < 2; ++a)
#pragma unroll
        for (int b = 0; b < 2; ++b)
#pragma unroll
            for (int m = 0; m < 4; ++m)
#pragma unroll
                for (int n = 0; n < 2; ++n) acc[a][b][m][n] = (f32x4){0.f, 0.f, 0.f, 0.f};
    bf16x8 At[4][2], B0[2][2], B1[2][2];
    unsigned gofs[2][2] = {{0u, 0u}, {0u, 0u}}, ngofs[2][2] = {{0u, 0u}, {0u, 0u}};
    if constexpr (Sched::GATHER) { PG8_GOFS(gofs, cur); }
    const char* cA = (const char*)g.A + (Sched::GATHER ? (size_t)0 : (size_t)cur.pm * tstep + (size_t)cur.e * g.astride + (size_t)cur.ko); const char* nA = cA;
    const char* cB = (const char*)g.Bt + (size_t)cur.e * g.bstride + (size_t)cur.pn * tstep + (size_t)cur.ko;
    if constexpr (PG8_SP2) {
    PG8_STAGE(PG8_SB(0, 0), cB, voffB); PG8_STAGE(PG8_SB(0, 1), cB + hstep, voffB); PG8_STAGE_A(PG8_SA(0, 0), false, 0, 0); PG8_STAGE_A(PG8_SA(0, 1), false, 1, 0);
    if (wr == 1) PG8_BAR;
    PG8_WAIT_V(2); PG8_BAR;
    PG8_STAGE(PG8_SB(1, 0), cB + kstep, voffB); PG8_STAGE_A(PG8_SA(1, 0), false, 0, 1); PG8_STAGE(PG8_SB(1, 1), cB + hstep + kstep, voffB);
    PG8_WAIT_V(6); PG8_BAR;
    } else {
    PG8_STAGE(PG8_SB(0, 0), cB, voffB); PG8_STAGE_A(PG8_SA(0, 0), false, 0, 0); PG8_STAGE(PG8_SB(0, 1), cB + hstep, voffB); PG8_STAGE_A(PG8_SA(0, 1), false, 1, 0);
    if (wr == 1) PG8_BAR;
    PG8_WAIT_V(4); PG8_BAR;
    PG8_STAGE(PG8_SB(1, 0), cB + kstep, voffB); PG8_STAGE_A(PG8_SA(1, 0), false, 0, 1); PG8_STAGE(PG8_SB(1, 1), cB + hstep + kstep, voffB);
    PG8_WAIT_V(6); PG8_BAR;
    }
    for (;;) {
        const bool has_next = S.next(ui + 1, nxt);
        if constexpr (Sched::GATHER) { if (has_next) { PG8_GOFS(ngofs, nxt); } else { _Pragma("unroll") for (int _h = 0; _h < 2; ++_h) _Pragma("unroll") for (int _i = 0; _i < 2; ++_i) ngofs[_h][_i] = gofs[_h][_i]; } }
        else { nA = has_next ? (const char*)g.A + (size_t)nxt.pm * tstep + (size_t)nxt.e * g.astride + (size_t)nxt.ko : cA; }
        const char* nB = has_next ? (const char*)g.Bt + (size_t)nxt.e * g.bstride + (size_t)nxt.pn * tstep + (size_t)nxt.ko : cB;
        for (int t = 0; t < nt; t += 2) {
            const bool last = (t == nt - 2);
            const char* b2 = last ? nB : cB + (size_t)(t + 2) * kstep; const char* b3 = b2 + kstep;
            const int kt2 = last ? 0 : t + 2, kt3 = kt2 + 1;
            if constexpr (PG8_SP2) {
            PG8_LDB(B0, 0, 0); PG8_LDB(B1, 0, 1); PG8_SCHED; PG8_LDA(At, 0, 0); PG8_STAGE_A(PG8_SA(1, 1), false, 1, t + 1);
            PG8_WAIT_V(8); PG8_WAIT_L(0); PG8_BAR; PG8_MMAP(0, 0, At, B0, true, false); PG8_MMAP(0, 1, At, B1, false, true); PG8_BAR; PG8_SCHED;
            PG8_LDA(At, 0, 1); PG8_STAGE(PG8_SB(0, 0), b2, voffB); PG8_STAGE(PG8_SB(0, 1), b2 + hstep, voffB); PG8_STAGE_A(PG8_SA(0, 0), last, 0, kt2);
            PG8_WAIT_V(8); PG8_WAIT_L(0); PG8_BAR; PG8_MMAP(1, 0, At, B0, true, false); PG8_MMAP(1, 1, At, B1, false, true); PG8_BAR; PG8_SCHED;
            PG8_LDB(B0, 1, 0); PG8_LDB(B1, 1, 1); PG8_SCHED; PG8_LDA(At, 1, 0); PG8_STAGE_A(PG8_SA(0, 1), last, 1, kt2);
            PG8_WAIT_V(8); PG8_WAIT_L(0); PG8_BAR; PG8_MMAP(0, 0, At, B0, true, false); PG8_MMAP(0, 1, At, B1, false, true); PG8_BAR; PG8_SCHED;
            PG8_LDA(At, 1, 1); PG8_STAGE(PG8_SB(1, 0), b3, voffB); PG8_STAGE(PG8_SB(1, 1), b3 + hstep, voffB); PG8_STAGE_A(PG8_SA(1, 0), last, 0, kt3);
            PG8_WAIT_V(8); PG8_WAIT_L(0); PG8_BAR; PG8_MMAP(1, 0, At, B0, true, false); PG8_MMAP(1, 1, At, B1, false, true); PG8_BAR; PG8_SCHED;
            } else {
            PG8_LDB(B0, 0, 0); PG8_SCHED; PG8_LDA(At, 0, 0); PG8_STAGE_A(PG8_SA(1, 1), false, 1, t + 1);
            PG8_WAIT_L(8); PG8_BAR; PG8_WAIT_L(0); PG8_MMA(0, 0, At, B0); PG8_BAR; PG8_SCHED;
            PG8_LDB(B1, 0, 1); PG8_STAGE(PG8_SB(0, 0), b2, voffB);
            PG8_BAR; PG8_WAIT_L(0); PG8_MMA(0, 1, At, B1); PG8_BAR;
            PG8_LDA(At, 0, 1); PG8_STAGE_A(PG8_SA(0, 0), last, 0, kt2);
            PG8_BAR; PG8_WAIT_L(0); PG8_MMA(1, 0, At, B0); PG8_BAR; PG8_SCHED;
            PG8_STAGE(PG8_SB(0, 1), b2 + hstep, voffB);
            PG8_WAIT_V(6); PG8_BAR; PG8_MMA(1, 1, At, B1); PG8_BAR;
            PG8_LDB(B0, 1, 0); PG8_SCHED; PG8_LDA(At, 1, 0); PG8_STAGE_A(PG8_SA(0, 1), last, 1, kt2);
            PG8_WAIT_L(8); PG8_BAR; PG8_WAIT_L(0); PG8_MMA(0, 0, At, B0); PG8_BAR; PG8_SCHED;
            PG8_LDB(B1, 1, 1); PG8_STAGE(PG8_SB(1, 0), b3, voffB);
            PG8_BAR; PG8_WAIT_L(0); PG8_MMA(0, 1, At, B1); PG8_BAR;
            PG8_LDA(At, 1, 1); PG8_STAGE_A(PG8_SA(1, 0), last, 0, kt3);
            PG8_BAR; PG8_WAIT_L(0); PG8_MMA(1, 0, At, B0); PG8_BAR; PG8_SCHED;
            PG8_STAGE(PG8_SB(1, 1), b3 + hstep, voffB);
            PG8_WAIT_V(6); PG8_BAR; PG8_MMA(1, 1, At, B1); PG8_BAR;
            }
        }
        if (wr == 0) PG8_BAR;
        if constexpr (FP8) {
#pragma unroll
            for (int a = 0; a < 2; ++a)
#pragma unroll
                for (int b = 0; b < 2; ++b) asm volatile("s_nop 15\n\ts_nop 15" : "+v"(acc[a][b][0][0]), "+v"(acc[a][b][0][1]), "+v"(acc[a][b][1][0]), "+v"(acc[a][b][1][1]), "+v"(acc[a][b][2][0]), "+v"(acc[a][b][2][1]), "+v"(acc[a][b][3][0]), "+v"(acc[a][b][3][1]));
        }
        const bool keep = E(acc, cur, wr, wc, fr, fq);
        if (!has_next) break;
        if (!keep) {
#pragma unroll
        for (int a = 0; a < 2; ++a)
#pragma unroll
            for (int b = 0; b < 2; ++b)
#pragma unroll
                for (int m = 0; m < 4; ++m)
#pragma unroll
                    for (int n = 0; n < 2; ++n) acc[a][b][m][n] = (f32x4){0.f, 0.f, 0.f, 0.f};
        }
        cur = nxt; cA = nA; cB = nB; ++ui;
        if constexpr (Sched::GATHER) { _Pragma("unroll") for (int _h = 0; _h < 2; ++_h) _Pragma("unroll") for (int _i = 0; _i < 2; ++_i) gofs[_h][_i] = ngofs[_h][_i]; }
        if (wr == 1) PG8_BAR;
    }
    PG8_WAIT_V(0);
    PG8_BAR;
#undef PG8_SA
#undef PG8_SB
#undef PG8_STAGE
#undef PG8_STAGE_A
#undef PG8_LDA
#undef PG8_LDB
#undef PG8_MMA
#undef PG8_MMAP
#undef PG8_WAIT_V
#undef PG8_WAIT_L
#undef PG8_BAR
#undef PG8_SCHED
#undef PG8_GOFS
}
}

namespace att {
constexpr int D = 128, NW = 8, QBLK = 32, KVBLK = 64, QB = NW * QBLK;
constexpr int SHM_V = KVBLK * D * 2, SHM_K = KVBLK * D * 2;
constexpr int ATT_WS_OFF = 2 * SHM_V + 2 * SHM_K;
constexpr int ATT_BIAS_OFF = ATT_WS_OFF + NW * 64 * 4;
constexpr int ATT_LDS_BYTES = ATT_BIAS_OFF + 4 * 128 * 4;
constexpr float SCALE = 0.08838834764831845f;
constexpr float THR = 8.f;
constexpr int WBIG = 1 << 30;

#define KSWZ(row, colB) ((row) * 256 + ((colB) ^ (((row) & 7) << 4)))
#define SBAR() __builtin_amdgcn_sched_barrier(0)
__device__ __forceinline__ int v_st(int k, int c) { const int kk = (k & ~0xC) | ((k & 4) << 1) | ((k & 8) >> 1); return ((kk >> 3) * 4 + (c >> 5)) * 512 + ((kk & 7) * 32 + (c & 31)) * 2; }
__device__ __forceinline__ int v_rd_base(int lane) { return ((lane & 3) << 3) | (((lane >> 2) & 3) << 6) | (((lane >> 4) & 1) << 5) | (((lane >> 5) & 1) << 8); }
constexpr int v_rd_off(int d0, int ks, int half) { return d0 * 512 + ks * 4096 + half * 2048; }
__device__ __forceinline__ int crow(int r, int hi) { return (r & 3) + 8 * (r >> 2) + 4 * hi; }
__device__ __forceinline__ unsigned cvtpk(float lo, float hi) { unsigned r; asm volatile("v_cvt_pk_bf16_f32 %0, %1, %2" : "=v"(r) : "v"(lo), "v"(hi)); return r; }
__device__ __forceinline__ bf16x8 load8(const bf16_t* p) { return *reinterpret_cast<const bf16x8*>(p); }

template <bool BIAS>
__device__ __forceinline__ void mask_tile(f32x16& p0, f32x16& p1, int dq, unsigned W, const float* btab) {
    const float NEG = -__builtin_inff();
#pragma unroll
    for (int r = 0; r < 16; ++r) {
        const int c = (r & 3) + 8 * (r >> 2);
        const unsigned d0 = (unsigned)(dq - c), d1 = (unsigned)(dq - c - 32);
        if (d0 >= W) p0[r] = NEG;
        if (d1 >= W) p1[r] = NEG;
    }
}
__device__ __forceinline__ void partialSM(f32x16& p0, f32x16& p1, float& m_reg, float& mn, float& alpha) {
    float pmax = p0[0]; for (int r = 1; r < 16; ++r) pmax = fmaxf(pmax, p0[r]); for (int r = 0; r < 16; ++r) pmax = fmaxf(pmax, p1[r]);
    { auto rr = __builtin_amdgcn_permlane32_swap(__float_as_uint(pmax), __float_as_uint(pmax), false, false);
      pmax = fmaxf(__uint_as_float(rr[0]), __uint_as_float(rr[1])); }
    constexpr float C2 = 1.4426950408889634f * SCALE;
    if (__builtin_expect(__all((pmax - m_reg) * SCALE <= THR), 1)) { mn = m_reg; alpha = 1.f; }
    else { mn = fmaxf(m_reg, pmax); alpha = __builtin_amdgcn_exp2f((m_reg - mn) * C2); m_reg = mn; }
    const float mnL = -mn * C2;
    for (int r = 0; r < 16; ++r) p0[r] = fmaf(p0[r], C2, mnL); for (int r = 0; r < 16; ++r) p1[r] = fmaf(p1[r], C2, mnL);
    for (int r = 0; r < 16; ++r) p0[r] = __builtin_amdgcn_exp2f(p0[r]);
}
__device__ __forceinline__ void finishSM(f32x16& p0, f32x16& p1, float alpha, float& l_reg, bf16x8& pa0, bf16x8& pa1, bf16x8& pa2, bf16x8& pa3) {
    for (int r = 0; r < 16; ++r) p1[r] = __builtin_amdgcn_exp2f(p1[r]);
    float ps = 0; for (int r = 0; r < 16; ++r) ps += p0[r]; for (int r = 0; r < 16; ++r) ps += p1[r];
    { auto rr = __builtin_amdgcn_permlane32_swap(__float_as_uint(ps), __float_as_uint(ps), false, false);
      ps = __uint_as_float(rr[0]) + __uint_as_float(rr[1]); }
    l_reg = l_reg * alpha + ps;
#define PK4(P, B_, OUT) do { unsigned a0 = cvtpk(P[B_+0], P[B_+1]), a1 = cvtpk(P[B_+2], P[B_+3]);                          \
        unsigned b0 = cvtpk(P[B_+4], P[B_+5]), b1 = cvtpk(P[B_+6], P[B_+7]);                                             \
        auto r0 = __builtin_amdgcn_permlane32_swap(a0, b0, false, false); auto r1 = __builtin_amdgcn_permlane32_swap(a1, b1, false, false); \
        u32x4 w = {r0[0], r1[0], r0[1], r1[1]}; OUT = *reinterpret_cast<bf16x8*>(&w); } while (0)
    PK4(p0, 0, pa0); PK4(p0, 8, pa1); PK4(p1, 0, pa2); PK4(p1, 8, pa3);
#undef PK4
}
template <int KB, bool BIAS>
__device__ __forceinline__ void qkt(f32x16& p0, f32x16& p1, const char* K_lds, int r32, int hi, const bf16x8* qr, bool need, int dq, const float* btab) {
    p0 = f32x16{}; p1 = f32x16{};
    if (BIAS && need) {
#pragma unroll
        for (int r = 0; r < 16; ++r) { const int c = (r & 3) + 8 * (r >> 2); const unsigned d0 = (unsigned)(dq - c), d1 = (unsigned)(dq - c - 32);
            p0[r] = btab[d0 < 127u ? d0 : 127u]; p1[r] = btab[d1 < 127u ? d1 : 127u]; }
    }
    const char* kb[4];
#pragma unroll
    for (int dd = 0; dd < 4; ++dd) kb[dd] = K_lds + KB * SHM_K + KSWZ(r32, (dd * 16 + hi * 8) * 2);
#pragma unroll
    for (int d0 = 0; d0 < 8; ++d0) { const char* a = kb[d0 & 3] + (d0 >> 2) * 128;
        bf16x8 b0 = *reinterpret_cast<const bf16x8*>(a);
        bf16x8 b1 = *reinterpret_cast<const bf16x8*>(a + 32 * 256);
        p0 = __builtin_amdgcn_mfma_f32_32x32x16_bf16(b0, qr[d0], p0, 0, 0, 0);
        p1 = __builtin_amdgcn_mfma_f32_32x32x16_bf16(b1, qr[d0], p1, 0, 0, 0); }
}
template <int VB>
__device__ __forceinline__ void pv_tile(f32x16* o, int vb0, bf16x8 pa0, bf16x8 pa1, bf16x8 pa2, bf16x8 pa3) {
#define TRRD(dst, off) asm volatile("ds_read_b64_tr_b16 %0, %1 offset:%2" : "=&v"(dst) : "v"(vb0), "i"(off) : "memory")
#define PV_D0(d0) do { s16x4 l0, l1, l2, l3, h0, h1, h2, h3; constexpr int b_ = VB * SHM_V + v_rd_off(d0, 0, 0); \
        TRRD(l0, b_); TRRD(h0, b_ + 2048); TRRD(l1, b_ + 4096); TRRD(h1, b_ + 6144); TRRD(l2, b_ + 8192); TRRD(h2, b_ + 10240); TRRD(l3, b_ + 12288); TRRD(h3, b_ + 14336); \
        asm volatile("s_waitcnt lgkmcnt(0)" ::: "memory"); SBAR();   \
        o[d0] = __builtin_amdgcn_mfma_f32_32x32x16_bf16(pa0, (bf16x8){l0[0], l0[1], l0[2], l0[3], h0[0], h0[1], h0[2], h0[3]}, o[d0], 0, 0, 0);   \
        o[d0] = __builtin_amdgcn_mfma_f32_32x32x16_bf16(pa1, (bf16x8){l1[0], l1[1], l1[2], l1[3], h1[0], h1[1], h1[2], h1[3]}, o[d0], 0, 0, 0);   \
        o[d0] = __builtin_amdgcn_mfma_f32_32x32x16_bf16(pa2, (bf16x8){l2[0], l2[1], l2[2], l2[3], h2[0], h2[1], h2[2], h2[3]}, o[d0], 0, 0, 0);   \
        o[d0] = __builtin_amdgcn_mfma_f32_32x32x16_bf16(pa3, (bf16x8){l3[0], l3[1], l3[2], l3[3], h3[0], h3[1], h3[2], h3[3]}, o[d0], 0, 0, 0); } while (0)
    PV_D0(0); PV_D0(1); PV_D0(2); PV_D0(3);
#undef PV_D0
#undef TRRD
}

struct BlockRef { const bf16_t* Q; const bf16_t* K; const bf16_t* V; bf16_t* O; int P0; const float* btab; };
struct Seam { bf16x8 qr[8]; bf16x8 st_v0, st_v1, st_k0, st_k1; };
template <int PQ_, int PKV_, int PO_> struct Pitch { static constexpr int q = PQ_, kv = PKV_, o = PO_; };
__device__ __forceinline__ int swa_jlo(int P0, int W) { const int lowk = P0 - W + 1; return lowk > 0 ? lowk / KVBLK : 0; }
#define ROWP(p, k0, rr) ((p) + (size_t)((k0) + (rr)) * PT.kv + sc)
#define VMW() asm volatile("s_waitcnt vmcnt(0)" ::: "memory")
#define VMWN(n) asm volatile("s_waitcnt vmcnt(%0)" :: "i"(n) : "memory")
#define SLOAD_H(Kp, Vp, k0) do { S.st_v0 = load8(ROWP(Vp, k0, sr)); S.st_v1 = load8(ROWP(Vp, k0, 32 + sr));              \
                         S.st_k0 = load8(ROWP(Kp, k0, sr)); S.st_k1 = load8(ROWP(Kp, k0, 32 + sr)); } while (0)
#define SWRITE_HK(bf) do { *(bf16x8*)(K_lds + (bf) * SHM_K + kws) = S.st_k0; *(bf16x8*)(K_lds + (bf) * SHM_K + kws + 32 * 256) = S.st_k1; } while (0)
#define SWRITE_HV(bf) do { *(bf16x8*)(V_lds + (bf) * SHM_V + vst0) = S.st_v0; *(bf16x8*)(V_lds + (bf) * SHM_V + vst1) = S.st_v1; } while (0)
#define SWRITE_H(bf) do { SWRITE_HV(bf); SWRITE_HK(bf); } while (0)
template <class PTt>
__device__ __forceinline__ void attn_prime(const BlockRef& cur, int W, char* lds, Seam& S, const int wid) {
    constexpr PTt PT{};
    const int lane = lane_id_opaque(), tid = (wid << 6) | lane, r32 = lane & 31, hi = lane >> 5;
    const int sr = tid >> 4, sc = (tid & 15) * 8, kws = KSWZ(sr, sc * 2); char* K_lds = lds + 2 * SHM_V;
    const int kb0 = swa_jlo(cur.P0, W) * KVBLK;
    for (int d0 = 0; d0 < 8; ++d0) S.qr[d0] = load8(cur.Q + (size_t)(wid * QBLK + r32) * PT.q + d0 * 16 + hi * 8);
    SLOAD_H(cur.K, cur.V, kb0); VMW(); SWRITE_HK(0);
    __syncthreads();
}
template <bool BIAS, class PTt>
__device__ __forceinline__ void attn_block(const BlockRef& cur, const BlockRef& nxt, int skv, int W, char* lds, Seam& S, const int wid) {
    constexpr PTt PT{};
    const int lane = lane_id_opaque(), tid = (wid << 6) | lane, r32 = lane & 31, hi = lane >> 5;
    const int j_lo = swa_jlo(cur.P0, W);
    int j_hi = (cur.P0 + QB - 1) / KVBLK + 1; if (j_hi > skv / KVBLK) j_hi = skv / KVBLK;
    const int NT = j_hi - j_lo;
    const int kbn = swa_jlo(nxt.P0, W) * KVBLK;
    const int qlo = cur.P0 + wid * QBLK, qm = qlo + r32 - 4 * hi;
    char* V_lds = lds; char* K_lds = lds + 2 * SHM_V;
    float* ws = (float*)(lds + ATT_WS_OFF) + wid * 64; float* li_l = ws, * al_l = ws + 32;
    float m_reg = -1e30f, l_reg = 0; f32x16 o[4] = {};
    const int sr = tid >> 4, sc = (tid & 15) * 8, vst0 = v_st(sr, sc), vst1 = v_st(32 + sr, sc), kws = KSWZ(sr, sc * 2);
    const int vb0 = (int)(uintptr_t)V_lds + v_rd_base(lane);
    const bf16_t* Kh = cur.K; const bf16_t* Vh = cur.V; const float* btab = cur.btab;
#define RESC(a) do { if (__any((a) < 1.f)) { if (hi == 0) al_l[r32] = (a); asm volatile("s_waitcnt lgkmcnt(0)" ::: "memory");              \
                     for (int d_ = 0; d_ < 4; ++d_) for (int r = 0; r < 16; ++r) o[d_][r] *= al_l[crow(r, hi)]; } } while (0)
#define KBASE(t) ((j_lo + (t)) * KVBLK)
#define MASKT(P0_, P1_, t) do { const int kb_ = KBASE(t); if (kb_ + KVBLK - 1 > qlo || kb_ <= qlo + QBLK - 1 - W) mask_tile<BIAS>(P0_, P1_, qm - kb_, (unsigned)W, btab); } while (0)
#define NEEDB(t) (BIAS && KBASE(t) + KVBLK - 1 + 113 > qlo)
#define QKT(KB_, PX0, PX1, t) qkt<KB_, BIAS>(PX0, PX1, K_lds, r32, hi, S.qr, NEEDB(t), qm - KBASE(t), btab)
    constexpr int NQL = 8;
#define SEAM_K0() do { VMWN(NQL); SWRITE_HK(0); SBAR(); } while (0)
    f32x16 pA0, pA1, pB0, pB1; float mnA, mnB, alA, alB; bf16x8 pa0, pa1, pa2, pa3;
    SWRITE_HV(0); SBAR();
    if (NT > 1) { SLOAD_H(Kh, Vh, KBASE(1)); }
    SBAR(); QKT(0, pA0, pA1, 0);
    MASKT(pA0, pA1, 0); partialSM(pA0, pA1, m_reg, mnA, alA);
    if (NT > 1) { VMW(); SWRITE_H(1); }
    __syncthreads();
#define HALF_STEP(PX0, PX1, mnX, alX, PY0, PY1, alY, t, KB, VB, SB) do {                                                      \
        SBAR(); QKT(KB, PX0, PX1, (t));                                                                           \
        finishSM(PY0, PY1, alY, l_reg, pa0, pa1, pa2, pa3); SBAR();                                                           \
        if ((t) + 1 < NT) { SLOAD_H(Kh, Vh, KBASE((t) + 1)); SBAR(); }                                                        \
        pv_tile<VB>(o, vb0, pa0, pa1, pa2, pa3); MASKT(PX0, PX1, (t)); partialSM(PX0, PX1, m_reg, mnX, alX);                  \
        __syncthreads();                                                                                                      \
        if ((t) + 1 < NT) { VMW(); SWRITE_H(SB); }                                                                            \
        RESC(alX); __syncthreads(); } while (0)
    for (int t = 1; t + 1 < NT; t += 2) {
        HALF_STEP(pB0, pB1, mnB, alB, pA0, pA1, alA, t, 1, 0, 0);
        HALF_STEP(pA0, pA1, mnA, alA, pB0, pB1, alB, t + 1, 0, 1, 1);
    }
    const bool even = (NT & 1) == 0;
    if (even) { SBAR(); QKT(1, pB0, pB1, NT - 1); SBAR(); }
    SLOAD_H(nxt.K, nxt.V, kbn); SBAR();
#pragma unroll
    for (int d0 = 0; d0 < 8; ++d0) S.qr[d0] = load8(nxt.Q + (size_t)(wid * QBLK + r32) * PT.q + d0 * 16 + hi * 8);
    SBAR();
    finishSM(pA0, pA1, alA, l_reg, pa0, pa1, pa2, pa3); SBAR();
    pv_tile<0>(o, vb0, pa0, pa1, pa2, pa3);
    if (even) { MASKT(pB0, pB1, NT - 1); partialSM(pB0, pB1, m_reg, mnB, alB); __syncthreads(); RESC(alB);
        finishSM(pB0, pB1, alB, l_reg, pa0, pa1, pa2, pa3); SBAR(); pv_tile<1>(o, vb0, pa0, pa1, pa2, pa3); }
    SBAR(); SEAM_K0();
    if (hi == 0) li_l[r32] = l_reg; asm volatile("s_waitcnt lgkmcnt(0)" ::: "memory");
    float rli[16];
#pragma unroll
    for (int r = 0; r < 16; ++r) rli[r] = __builtin_amdgcn_rcpf(li_l[crow(r, hi)]);
    bf16_t* Ow = cur.O + (size_t)(wid * QBLK) * PT.o;
#pragma unroll
    for (int r = 0; r < 16; ++r) { const int orow = crow(r, hi);
#pragma unroll
        for (int d0 = 0; d0 < 4; ++d0) { const float v = o[d0][r] * rli[r];
            const float vn = __int_as_float(__builtin_amdgcn_ds_swizzle(__float_as_int(v), 0x041F));
            if ((r32 & 1) == 0) *(unsigned*)(Ow + (size_t)orow * PT.o + d0 * 32 + r32) = cvtpk(v, vn); } }
    __syncthreads();
#undef RESC
#undef KBASE
#undef MASKT
#undef NEEDB
#undef QKT
#undef SEAM_K0
#undef HALF_STEP
}
#undef ROWP
#undef VMW
#undef VMWN
#undef SLOAD_H
#undef SWRITE_HK
#undef SWRITE_HV
#undef SWRITE_H
}

namespace att2 {
using att::crow; using att::cvtpk; using att::load8; using att::v_rd_base; using att::SCALE; using att::THR;
constexpr int D = 128, DV = 256, KVBLK = 64, QROWS = 128;
constexpr int SHM_K = KVBLK * D * 2, SHM_V = KVBLK * DV * 2;
constexpr int OFF_K = 0, OFF_V = 2 * SHM_K;
constexpr int OFF_XM = OFF_V + 2 * SHM_V;
constexpr int OFF_XS = OFF_XM + 1024;
constexpr int OFF_XPA = OFF_XS + 1024;
constexpr int OFF_WS = OFF_XPA + 16384;
constexpr int OFF_BIAS = OFF_WS + 2048;
constexpr int LDS_END = OFF_BIAS + 2048;
__device__ __forceinline__ int v_st2(int k, int c) { const int kk = (k & ~0xC) | ((k & 4) << 1) | ((k & 8) >> 1); return ((kk >> 3) * 8 + (c >> 5)) * 512 + ((kk & 7) * 32 + (c & 31)) * 2; }
struct Blk { const bf16_t* Q; const bf16_t* K; const bf16_t* V; bf16_t* O; int P0; const float* btab; };

__device__ __forceinline__ void attn_block(const Blk& B, char* lds, LAS unsigned char* ldsl, const int wid, const bool pre, const bool pf) {
    constexpr int LDQ = 256, LDKV = 256, LDO = 2048;
    const int lane = lane_id_opaque(), tid = (wid << 6) | lane, r32 = lane & 31, hi = lane >> 5, pr = wid >> 1, sh = wid & 1;
    char* K_lds = lds + OFF_K; char* V_lds = lds + OFF_V;
    float* xm = (float*)(lds + OFF_XM); float* xs = (float*)(lds + OFF_XS); char* xpa = lds + OFF_XPA;
    float* wsf = (float*)(lds + OFF_WS) + wid * 64; float* li_l = wsf; float* al_l = wsf + 32;
    const float* btab = B.btab;
    const int NT = (B.P0 + QROWS - 1) / KVBLK + 1;
    const int qlo = B.P0 + pr * 32, qm = qlo + r32 - 4 * hi;
    unsigned ksrc[2], vsrc[4];
#pragma unroll
    for (int i = 0; i < 2; ++i) { const int o = (wid * 2 + i) * 1024 + lane * 16; const int row = o >> 8, cs = (o >> 4) & 15; ksrc[i] = (unsigned)(row * (LDKV * 2) + ((cs ^ (row & 7)) << 4)); }
#pragma unroll
    for (int i = 0; i < 4; ++i) { const int o = (wid * 4 + i) * 1024 + lane * 16; const int st = o >> 9, r = (o >> 6) & 7, q = (o >> 4) & 3;
        const int kk = (st >> 3) * 8 + r, k = (kk & ~0xC) | ((kk & 4) << 1) | ((kk & 8) >> 1), c = (st & 7) * 32 + q * 8; vsrc[i] = (unsigned)(k * (LDKV * 2) + c * 2); }
    const int vb0 = (int)(uintptr_t)V_lds + v_rd_base(lane) + sh * 2048 + sh * 16384;
    const int vb1 = vb0 + 16384 - sh * 32768;
    bf16x8 qr[8];
    f32x16 o[4] = {}; float m_reg = -1e30f, l_reg = 0.f;
#define A2_DMA_K(bf, kb) do { const char* kp_ = (const char*)(B.K + (size_t)(kb) * LDKV); _Pragma("unroll") for (int i_ = 0; i_ < 2; ++i_) \
        __builtin_amdgcn_global_load_lds((const unsigned*)(kp_ + ksrc[i_]), (LAS unsigned*)(ldsl + OFF_K + (bf) * SHM_K + (wid * 2 + i_) * 1024), 16, 0, 0); } while (0)
#define A2_DMA_V(bf, kb) do { const char* vp_ = (const char*)(B.V + (size_t)(kb) * LDKV); _Pragma("unroll") for (int i_ = 0; i_ < 4; ++i_) \
        __builtin_amdgcn_global_load_lds((const unsigned*)(vp_ + vsrc[i_]), (LAS unsigned*)(ldsl + OFF_V + (bf) * SHM_V + (wid * 4 + i_) * 1024), 16, 0, 0); } while (0)
#define A2_VMW() asm volatile("s_waitcnt vmcnt(0)" ::: "memory")
#define A2_VMW2() asm volatile("s_waitcnt vmcnt(2)" ::: "memory")
#define A2_KB(t) ((t) * KVBLK)
#define A2_QK(KB_, P, t) do { const int kb_ = A2_KB(t); const int dqo_ = qm - kb_ - 32 * sh; \
        const char* kb4_[4]; _Pragma("unroll") for (int dd = 0; dd < 4; ++dd) kb4_[dd] = K_lds + (KB_) * SHM_K + KSWZ(32 * sh + r32, (dd * 16 + hi * 8) * 2); \
        if (kb_ + KVBLK - 1 + 113 > qlo) { _Pragma("unroll") for (int r = 0; r < 16; ++r) { const unsigned d_ = (unsigned)(dqo_ - ((r & 3) + 8 * (r >> 2))); P[r] = btab[d_ < 127u ? d_ : 127u]; } \
          _Pragma("unroll") for (int d0 = 0; d0 < 8; ++d0) { const bf16x8 kf_ = *reinterpret_cast<const bf16x8*>(kb4_[d0 & 3] + (d0 >> 2) * 128); \
              P = __builtin_amdgcn_mfma_f32_32x32x16_bf16(kf_, qr[d0], P, 0, 0, 0); } } \
        else {     \
          { const bf16x8 kf_ = *reinterpret_cast<const bf16x8*>(kb4_[0]); P = __builtin_amdgcn_mfma_f32_32x32x16_bf16(kf_, qr[0], f32x16{}, 0, 0, 0); } \
          _Pragma("unroll") for (int d0 = 1; d0 < 8; ++d0) { const bf16x8 kf_ = *reinterpret_cast<const bf16x8*>(kb4_[d0 & 3] + (d0 >> 2) * 128); \
              P = __builtin_amdgcn_mfma_f32_32x32x16_bf16(kf_, qr[d0], P, 0, 0, 0); } } } while (0)
#define A2_MX(P, t) do { const int kb_ = A2_KB(t); const int dqo_ = qm - kb_ - 32 * sh; \
        if (kb_ + KVBLK - 1 > qlo) { const float NEG_ = -__builtin_inff(); _Pragma("unroll") for (int r = 0; r < 16; ++r) { if ((unsigned)(dqo_ - ((r & 3) + 8 * (r >> 2))) >= 0x40000000u) P[r] = NEG_; } } \
        float pm_ = P[0]; _Pragma("unroll") for (int r = 1; r < 16; ++r) pm_ = fmaxf(pm_, P[r]); \
        { auto rr_ = __builtin_amdgcn_permlane32_swap(__float_as_uint(pm_), __float_as_uint(pm_), false, false); pm_ = fmaxf(__uint_as_float(rr_[0]), __uint_as_float(rr_[1])); } \
        pmloc = pm_; if (hi == 0) xm[wid * 32 + r32] = pm_; } while (0)
#define A2_SM1A(alX, DO) constexpr float C2 = 1.4426950408889634f * SCALE; float mnL_ = 0.f; \
        if (DO) { const float pmax_ = fmaxf(pmloc, xm[(wid ^ 1) * 32 + r32]); float mn_; \
            if (__builtin_expect(__all((pmax_ - m_reg) * SCALE <= THR), 1)) { mn_ = m_reg; alX = 1.f; } \
            else { mn_ = fmaxf(m_reg, pmax_); alX = __builtin_amdgcn_exp2f((m_reg - mn_) * C2); m_reg = mn_; } \
            mnL_ = -mn_ * C2; }
#define A2_SM1B(P, r0) do { _Pragma("unroll") for (int r = (r0); r < (r0) + 4; ++r) P[r] = __builtin_amdgcn_exp2f(fmaf(P[r], C2, mnL_)); } while (0)
#define A2_FIN(P) do { float ps_ = 0.f; _Pragma("unroll") for (int r = 0; r < 16; ++r) ps_ += P[r]; \
        { auto rr_ = __builtin_amdgcn_permlane32_swap(__float_as_uint(ps_), __float_as_uint(ps_), false, false); ps_ = __uint_as_float(rr_[0]) + __uint_as_float(rr_[1]); } \
        psown = ps_; if (hi == 0) xs[wid * 32 + r32] = ps_; \
        { unsigned a0_ = cvtpk(P[0], P[1]), a1_ = cvtpk(P[2], P[3]), b0_ = cvtpk(P[4], P[5]), b1_ = cvtpk(P[6], P[7]); \
          auto r0_ = __builtin_amdgcn_permlane32_swap(a0_, b0_, false, false); auto r1_ = __builtin_amdgcn_permlane32_swap(a1_, b1_, false, false); \
          u32x4 w_ = {r0_[0], r1_[0], r0_[1], r1_[1]}; paown0 = *reinterpret_cast<bf16x8*>(&w_); } \
        { unsigned a0_ = cvtpk(P[8], P[9]), a1_ = cvtpk(P[10], P[11]), b0_ = cvtpk(P[12], P[13]), b1_ = cvtpk(P[14], P[15]); \
          auto r0_ = __builtin_amdgcn_permlane32_swap(a0_, b0_, false, false); auto r1_ = __builtin_amdgcn_permlane32_swap(a1_, b1_, false, false); \
          u32x4 w_ = {r0_[0], r1_[0], r0_[1], r1_[1]}; paown1 = *reinterpret_cast<bf16x8*>(&w_); } \
        *(bf16x8*)(xpa + (wid * 2 + 0) * 1024 + lane * 16) = paown0; *(bf16x8*)(xpa + (wid * 2 + 1) * 1024 + lane * 16) = paown1; } while (0)
#define A2_TR(dst, vb, off) asm volatile("ds_read_b64_tr_b16 %0, %1 offset:%2" : "=&v"(dst) : "v"(vb), "i"(off) : "memory")
#define A2_TRL(VB_, d0, T) do { constexpr int b_ = (VB_) * SHM_V + (d0) * 512; \
        A2_TR(T##l0, vb0, b_); A2_TR(T##h0, vb0, b_ + 4096); A2_TR(T##l1, vb0, b_ + 8192); A2_TR(T##h1, vb0, b_ + 12288); A2_TR(T##l2, vb1, b_); A2_TR(T##h2, vb1, b_ + 4096); A2_TR(T##l3, vb1, b_ + 8192); A2_TR(T##h3, vb1, b_ + 12288); } while (0)
#define A2_MM(d0, T) do { \
        o[d0] = __builtin_amdgcn_mfma_f32_32x32x16_bf16(pa0_, (bf16x8){T##l0[0], T##l0[1], T##l0[2], T##l0[3], T##h0[0], T##h0[1], T##h0[2], T##h0[3]}, o[d0], 0, 0, 0); \
        o[d0] = __builtin_amdgcn_mfma_f32_32x32x16_bf16(pa1_, (bf16x8){T##l1[0], T##l1[1], T##l1[2], T##l1[3], T##h1[0], T##h1[1], T##h1[2], T##h1[3]}, o[d0], 0, 0, 0); \
        o[d0] = __builtin_amdgcn_mfma_f32_32x32x16_bf16(pa2_, (bf16x8){T##l2[0], T##l2[1], T##l2[2], T##l2[3], T##h2[0], T##h2[1], T##h2[2], T##h2[3]}, o[d0], 0, 0, 0); \
        o[d0] = __builtin_amdgcn_mfma_f32_32x32x16_bf16(pa3_, (bf16x8){T##l3[0], T##l3[1], T##l3[2], T##l3[3], T##h3[0], T##h3[1], T##h3[2], T##h3[3]}, o[d0], 0, 0, 0); } while (0)
#define A2_LW() do { asm volatile("s_waitcnt lgkmcnt(0)" ::: "memory"); __builtin_amdgcn_sched_barrier(0); } while (0)
#define A2_PV(VB_, alY, WITH_SM, PX, alX, PRE) do { \
        const bf16x8 pp0_ = *(const bf16x8*)(xpa + ((wid ^ 1) * 2 + 0) * 1024 + lane * 16), pp1_ = *(const bf16x8*)(xpa + ((wid ^ 1) * 2 + 1) * 1024 + lane * 16); \
        const float pso_ = xs[(wid ^ 1) * 32 + r32]; \
        A2_SM1A(alX, WITH_SM); \
        if (!(PRE)) A2_TRL(VB_, 0, X); \
        l_reg = l_reg * alY + (psown + pso_); \
        const bf16x8 pa0_ = paown0, pa1_ = paown1, pa2_ = pp0_, pa3_ = pp1_; \
        A2_LW(); \
        A2_TRL(VB_, 1, Y); A2_MM(0, X); if (WITH_SM) A2_SM1B(PX, 0); A2_LW(); \
        A2_TRL(VB_, 2, X); A2_MM(1, Y); if (WITH_SM) A2_SM1B(PX, 4); A2_LW(); \
        A2_TRL(VB_, 3, Y); A2_MM(2, X); if (WITH_SM) A2_SM1B(PX, 8); A2_LW(); \
        A2_MM(3, Y); if (WITH_SM) A2_SM1B(PX, 12); } while (0)
#define A2_RESC(a) do { if (__any((a) < 1.f)) { if (hi == 0) al_l[r32] = (a); asm volatile("s_waitcnt lgkmcnt(0)" ::: "memory"); \
        _Pragma("unroll") for (int d_ = 0; d_ < 4; ++d_) _Pragma("unroll") for (int r = 0; r < 16; ++r) o[d_][r] *= al_l[crow(r, hi)]; } } while (0)
    f32x16 PA, PB; float alA = 1.f, alB = 1.f, pmloc = 0.f, psown = 0.f; bf16x8 paown0, paown1;
    s16x4 Xl0, Xl1, Xl2, Xl3, Xh0, Xh1, Xh2, Xh3, Yl0, Yl1, Yl2, Yl3, Yh0, Yh1, Yh2, Yh3;
#pragma unroll
    for (int d0 = 0; d0 < 8; ++d0) qr[d0] = load8(B.Q + (size_t)(pr * 32 + r32) * LDQ + d0 * 16 + hi * 8);
    if (!pre) { A2_DMA_K(0, 0); A2_DMA_V(0, 0); }
    A2_VMW();
    __syncthreads();
    A2_DMA_K(1, A2_KB(1));
    A2_QK(0, PA, 0); A2_MX(PA, 0);
    __syncthreads();
    if (NT > 2) A2_DMA_K(0, A2_KB(2));
    { A2_SM1A(alA, true); A2_SM1B(PA, 0); A2_SM1B(PA, 4); A2_SM1B(PA, 8); A2_SM1B(PA, 12); }
    if (NT > 2) A2_VMW2(); else A2_VMW();
    __syncthreads();
    A2_DMA_V(1, A2_KB(1));
#define A2_STEP(PX, alX, PY, alY, t, KBX, VBY, more) do { \
        __builtin_amdgcn_sched_barrier(0); A2_QK(KBX, PX, t); A2_FIN(PY); A2_MX(PX, t); \
        A2_TRL(VBY, 0, X);     \
        __syncthreads(); \
        if ((t) + 2 < NT) A2_DMA_K(KBX, A2_KB((t) + 2));     \
        A2_PV(VBY, alY, true, PX, alX, true); \
        if ((t) + 2 < NT) A2_VMW2(); else A2_VMW(); \
        A2_RESC(alX); \
        __syncthreads(); \
        if (more) A2_DMA_V(VBY, A2_KB((t) + 1)); } while (0)
    for (int t = 1; t + 1 < NT; t += 2) {
        A2_STEP(PB, alB, PA, alA, t, 1, 0, true);
        A2_STEP(PA, alA, PB, alB, t + 1, 0, 1, true);
    }
    A2_STEP(PB, alB, PA, alA, NT - 1, 1, 0, false);
    A2_FIN(PB);
    if (pf) { A2_DMA_K(0, 0); A2_DMA_V(0, 0); }
    __syncthreads();
    { float aldummy = 1.f; A2_PV(1, alB, false, PB, aldummy, false); (void)aldummy; }
    if (hi == 0) li_l[r32] = l_reg; asm volatile("s_waitcnt lgkmcnt(0)" ::: "memory");
    float rli[16];
#pragma unroll
    for (int r = 0; r < 16; ++r) rli[r] = __builtin_amdgcn_rcpf(li_l[crow(r, hi)]);
    bf16_t* Ow = B.O + (size_t)(pr * 32) * LDO + sh * 128;
#pragma unroll
    for (int r = 0; r < 16; ++r) { const int orow = crow(r, hi);
#pragma unroll
        for (int d0 = 0; d0 < 4; ++d0) { const float v = o[d0][r] * rli[r];
            const float vn = __int_as_float(__builtin_amdgcn_ds_swizzle(__float_as_int(v), 0x041F));
            if ((r32 & 1) == 0) *(unsigned*)(Ow + (size_t)orow * LDO + d0 * 32 + r32) = cvtpk(v, vn); } }
    __syncthreads();
#undef A2_DMA_K
#undef A2_DMA_V
#undef A2_VMW
#undef A2_VMW2
#undef A2_KB
#undef A2_QK
#undef A2_MX
#undef A2_SM1A
#undef A2_SM1B
#undef A2_TRL
#undef A2_MM
#undef A2_LW
#undef A2_FIN
#undef A2_PV
#undef A2_TR
#undef A2_RESC
#undef A2_STEP
}
}

#define XB_TMO      128
#define XB_XCNT(j)  (256  + 64 * (j))
#define XB_XSUB(j)  (1280 + 64 * (j))
#define XB_XGEN(j)  (2304 + 64 * (j))
#define XB_TOP      3328
#define XB_TOPGEN   3392
#define XCD_BAR_WORDS 3456
#define XB_SPIN_CAP (1u << 18)
__device__ __forceinline__ unsigned xb_ld(unsigned* p)              { return __hip_atomic_load(p, __ATOMIC_RELAXED, __HIP_MEMORY_SCOPE_AGENT); }
__device__ __forceinline__ unsigned xb_add(unsigned* p, unsigned v) { return __hip_atomic_fetch_add(p, v, __ATOMIC_RELAXED, __HIP_MEMORY_SCOPE_AGENT); }
__device__ __forceinline__ unsigned xb_xcc_id() { return (unsigned)__builtin_amdgcn_s_getreg((3 << 11) | 20) & 0xFu; }
#define XB_SPIN(cond, bar) do { unsigned _sp = 0; while (cond) { __builtin_amdgcn_s_sleep(1); \
    if ((++_sp & 255u) == 0u) { if (xb_ld(&(bar)[XB_TMO])) break; if (_sp > XB_SPIN_CAP) { atomicAdd(&(bar)[XB_TMO], 1u); break; } } } } while (0)
struct XcdBarrier { unsigned* bar; unsigned x; volatile LAS unsigned* st; int wv; };
__device__ __forceinline__ XcdBarrier xcd_barrier_post(unsigned* bar, volatile LAS unsigned* st) {
    XcdBarrier b; b.bar = bar; b.x = xb_xcc_id(); b.st = st; b.wv = 0;
    if (threadIdx.x == 0) (void)xb_add(&bar[XB_XCNT(b.x)], 1u);
    return b;
}
__device__ __forceinline__ void xcd_barrier_complete(unsigned* bar, unsigned x, unsigned& nloc, unsigned& nx) {
    const unsigned G = gridDim.x * gridDim.y * gridDim.z;
    unsigned sum, cnt, mine, sp = 0u;
    for (;;) {
        sum = 0u; cnt = 0u; mine = 0u;
#pragma unroll
        for (unsigned j = 0; j < 16; ++j) { const unsigned c = xb_ld(&bar[XB_XCNT(j)]); sum += c; cnt += (c > 0u) ? 1u : 0u; mine = (j == x) ? c : mine; }
        if (sum == G) break;
        __builtin_amdgcn_s_sleep(1);
        if ((++sp & 255u) == 0u) { if (xb_ld(&bar[XB_TMO])) break; if (sp > XB_SPIN_CAP) { atomicAdd(&bar[XB_TMO], 1u); break; } }
    }
    nloc = mine > 0u ? mine : 1u; nx = cnt > 0u ? cnt : 1u;
}
__device__ __forceinline__ void xcd_barrier(const XcdBarrier& b) {
    asm volatile("s_waitcnt vmcnt(0)" ::: "memory");
    __syncthreads();
    if (b.wv == 0 && lane_id_opaque() == 0) {
        unsigned* bar = b.bar;
        __builtin_amdgcn_s_waitcnt(0);
        unsigned nloc = b.st[0], nx = b.st[1];
        if (nloc == 0u) { xcd_barrier_complete(bar, b.x, nloc, nx); b.st[0] = nloc; b.st[1] = nx; }
        const unsigned old = xb_add(&bar[XB_XSUB(b.x)], 1u);
        const unsigned gen = old / nloc;
        if (old + 1u == (gen + 1u) * nloc) {
            __builtin_amdgcn_fence(__ATOMIC_RELEASE, "agent");
            asm volatile("s_waitcnt vmcnt(0)" ::: "memory");
            const unsigned og = xb_add(&bar[XB_TOP], 1u);
            const unsigned tg = og / nx;
            if (og + 1u == (tg + 1u) * nx) xb_add(&bar[XB_TOPGEN], 1u);
            else XB_SPIN(xb_ld(&bar[XB_TOPGEN]) == tg, bar);
            __builtin_amdgcn_fence(__ATOMIC_ACQUIRE, "agent");
            xb_add(&bar[XB_XGEN(b.x)], 1u);
            asm volatile("s_waitcnt vmcnt(0)" ::: "memory");
        } else {
            XB_SPIN(xb_ld(&bar[XB_XGEN(b.x)]) == gen, bar);
            __builtin_amdgcn_fence(__ATOMIC_ACQUIRE, "agent");
            asm volatile("s_waitcnt vmcnt(0)" ::: "memory");
        }
    }
    __syncthreads();
}

struct Params {
    const float* x; const float* mem; const float* t5; const float* w_in; const float* w_conv; const float* dlam; const float* dsub;
    const float* w_branch; const float* w_mix; const float* w_xq; const float* w_xkv; const float* w_xo;
    const float* w_fg; const float* w_fu; const float* w_fd; const float* w_router; const float* w_eg; const float* w_eu; const float* w_ed;
    const float* g_pre_mix; const float* g_post_mix; const float* g_pre_x; const float* g_mem; const float* g_post_x; const float* g_pre_ffn; const float* g_post_ffn;
    float* out; unsigned char* ws; int ph_lo, ph_hi;
};
struct Ctx { int G, c, wv, dry; LAS unsigned char* lds; unsigned char* ws; int it0 = 0, it1 = 0x7fffffff; };
#define TID_INIT() const int lane = lane_id_opaque(); const int wave = X.wv; const int tid = (wave << 6) | lane; const int gw = X.c * 8 + wave; const int NGW = X.G * 8; (void)lane; (void)wave; (void)gw; (void)NGW

#ifndef FFN_GU_FP8
#define FFN_GU_FP8 1
#endif
#ifndef PROBE_CVT
#define PROBE_CVT 0
#endif
#define CVT_DECODE(it_, Wv, Nv, k0v, n0v, drowv, scv) do { \
        if (GU) { constexpr int nrb = 14336 / 64; const int kb_ = (it_) / nrb, rb_ = (it_) % nrb; const int r0_ = rb_ * 64, pn_ = r0_ >> 8, j0_ = r0_ & 255; \
            Wv = (j0_ < 128) ? W : W2; Nv = DFF; k0v = kb_ * 256; n0v = pn_ * 128 + (j0_ & 127); drowv = r0_; scv = scale; } \
        else { const int nnb_ = Nsrc / 64; const int kb_ = (it_) / nnb_, nb_ = (it_) % nnb_; Wv = W; Nv = Npitch; k0v = kb_ * 256; n0v = nb_ * 64; drowv = drow0 + nb_ * 64; scv = scale * ((nb_ * 64 < scols) ? cscale : 1.0f); } } while (0)
template <bool FP8, bool GU>
__device__ __forceinline__ void cvt_run(const Ctx& X, const float* W, const float* W2, int K, int Nsrc, int Npitch, unsigned char* dst, size_t dpitch_bytes, int drow0, int dcol0_bytes, const float* gain, int scols, float cscale, float scale, int rot) {
    TID_INIT();
    LAS float* scr = (LAS float*)X.lds;
    const int items_all = GU ? (DM / 256) * (14336 / 64) : (K / 256) * (Nsrc / 64); const int items = items_all < X.it1 ? items_all : X.it1;
    const int nl = (lane & 15) * 4, kr = lane >> 4;
    f32x4 v[8]; const float* Wc; int Nc, k0 = 0, n0, drow = 0; float sc = 1.f;
    int it = X.it0 + (X.c + rot) % X.G;
    if (it < items) { CVT_DECODE(it, Wc, Nc, k0, n0, drow, sc);
#pragma unroll
        for (int i = 0; i < 8; ++i) v[i] = __builtin_nontemporal_load((const f32x4*)(Wc + (size_t)(k0 + 32 * wave + 4 * i + kr) * Nc + n0 + nl)); }
    for (; it < items; it += X.G) {
#pragma unroll
        for (int i = 0; i < 8; ++i) { const int k = 32 * wave + 4 * i + kr; LAS float* s = scr + k * 65; const int rotn = nl + (k >> 3);
            s[(rotn + 0) & 63] = v[i][0]; s[(rotn + 1) & 63] = v[i][1]; s[(rotn + 2) & 63] = v[i][2]; s[(rotn + 3) & 63] = v[i][3]; }
        const int k0c = k0, drowc = drow; const float scc = sc;
        __syncthreads();
        if (it + X.G < items) { CVT_DECODE(it + X.G, Wc, Nc, k0, n0, drow, sc);
#pragma unroll
            for (int i = 0; i < 8; ++i) v[i] = __builtin_nontemporal_load((const f32x4*)(Wc + (size_t)(k0 + 32 * wave + 4 * i + kr) * Nc + n0 + nl)); }
        if (!(PROBE_CVT && X.dry == 1)) {
        if (FP8) { const int c = tid & 15, rr = tid >> 4;
            f32x4 g[4];
#pragma unroll
            for (int q = 0; q < 4; ++q) { g[q] = gain ? *(const f32x4*)(gain + k0c + 16 * c + 4 * q) : (f32x4){1.f, 1.f, 1.f, 1.f}; g[q] = g[q] * scc; }
#pragma unroll
            for (int ps = 0; ps < 2; ++ps) { const int n = 32 * ps + rr; float e[16];
#pragma unroll
                for (int j = 0; j < 16; ++j) { const int k = 16 * c + j; e[j] = scr[k * 65 + ((n + (k >> 3)) & 63)] * g[j >> 2][j & 3]; }
                u32x4 o; o.x = pk4_fp8(e[0], e[1], e[2], e[3]); o.y = pk4_fp8(e[4], e[5], e[6], e[7]); o.z = pk4_fp8(e[8], e[9], e[10], e[11]); o.w = pk4_fp8(e[12], e[13], e[14], e[15]);
                if (PROBE_CVT && X.dry == 2) asm volatile("" :: "v"(o)); else __builtin_nontemporal_store(o, (u32x4*)(dst + (size_t)(drowc + n) * dpitch_bytes + dcol0_bytes + k0c + 16 * c)); }
        } else { const int c = tid & 31, rr = tid >> 5;
            f32x4 g[2];
#pragma unroll
            for (int q = 0; q < 2; ++q) { g[q] = gain ? *(const f32x4*)(gain + k0c + 8 * c + 4 * q) : (f32x4){1.f, 1.f, 1.f, 1.f}; g[q] = g[q] * scc; }
#pragma unroll
            for (int ps = 0; ps < 4; ++ps) { const int n = 16 * ps + rr; float e[8];
#pragma unroll
                for (int j = 0; j < 8; ++j) { const int k = 8 * c + j; e[j] = scr[k * 65 + ((n + c) & 63)] * g[j >> 2][j & 3]; }
                u32x4 o; o.x = pk2(e[0], e[1]); o.y = pk2(e[2], e[3]); o.z = pk2(e[4], e[5]); o.w = pk2(e[6], e[7]);
                if (PROBE_CVT && X.dry == 2) asm volatile("" :: "v"(o)); else __builtin_nontemporal_store(o, (u32x4*)(dst + (size_t)(drowc + n) * dpitch_bytes + dcol0_bytes + (k0c + 8 * c) * 2)); }
        }
        }
        __syncthreads();
    }
}
__device__ __forceinline__ void cvt_matrix(const Ctx& X, const float* W, int K, int N, bf16_t* dst, size_t dpitch, int drow0, int dcol0, const float* gain, int scols, float cscale, int rot) {
    cvt_run<false, false>(X, W, nullptr, K, N, N, (unsigned char*)dst, dpitch * 2, drow0, dcol0 * 2, gain, scols, cscale, 1.0f, rot);
}
__device__ __forceinline__ void cvt_gateup(const Ctx& X, const float* Wg, const float* Wu, bf16_t* dst, const float* gain, int rot) {
    cvt_run<false, true>(X, Wg, Wu, DM, DFF, DFF, (unsigned char*)dst, (size_t)DM * 2, 0, 0, gain, 0, 1.0f, 1.0f, rot);
}
__device__ __forceinline__ void cvt_matrix8(const Ctx& X, const float* W, int K, int N, unsigned char* dst, size_t dpitch, const float* gain, float scale, int rot) {
    cvt_run<true, false>(X, W, nullptr, K, N, N, dst, dpitch, 0, 0, gain, 0, 1.0f, scale, rot);
}
__device__ __forceinline__ void cvt_gateup8(const Ctx& X, const float* Wg, const float* Wu, unsigned char* dst, const float* gain, float scale, int rot) {
    cvt_run<true, true>(X, Wg, Wu, DM, DFF, DFF, dst, (size_t)DM, 0, 0, gain, 0, 1.0f, scale, rot);
}
__device__ __forceinline__ void row_rmsnorm_to_bf16(const float* xrow, bf16_t* orow, int lane, unsigned char* orow8 = nullptr) {
    f32x4 v[8]; float s = 0.f;
#pragma unroll
    for (int j = 0; j < 8; ++j) { v[j] = *(const f32x4*)(xrow + j * 256 + lane * 4); s += (v[j][0] * v[j][0] + v[j][1] * v[j][1]) + (v[j][2] * v[j][2] + v[j][3] * v[j][3]); }
    const float rstd = 1.0f / sqrtf(wave_sum(s) * (1.0f / DM) + EPS);
#pragma unroll
    for (int j = 0; j < 8; ++j) { u32x2 w; w.x = pk2(v[j][0] * rstd, v[j][1] * rstd); w.y = pk2(v[j][2] * rstd, v[j][3] * rstd); *(u32x2*)(orow + j * 256 + lane * 4) = w;
        if (orow8) *(unsigned*)(orow8 + j * 256 + lane * 4) = pk4_fp8(v[j][0] * rstd, v[j][1] * rstd, v[j][2] * rstd, v[j][3] * rstd); }
}
constexpr int CVT_DEFER_ITEMS = 6 * (14336 / 64);
__device__ __forceinline__ bool cvt_deferred(int G) { return ONE_LAUNCH && G >= 192; }
__device__ __forceinline__ void phase_prologue(const Ctx& X, const Params& p) {
    TID_INIT();
    unsigned char* ws = X.ws;
    int rot = 0;
    for (int l = 0; l < DEPTH; ++l) {
        cvt_run<false, false>(X, p.w_in + (size_t)l * DM * NIN, nullptr, DM, NIN16, NIN, ws + WS_WIN + (size_t)l * NIN16 * DM * 2, (size_t)DM * 2, 0, 0, p.g_pre_mix + l * DM, 1024, 0.08838834764831845f, 1.0f, rot); rot += 37;
        cvt_run<true, false>(X, p.w_in + (size_t)l * DM * NIN + NIN16, nullptr, DM, NIN8, NIN, ws + WS_WIN8 + (size_t)l * NIN8 * DM, (size_t)DM, 0, 0, p.g_pre_mix + l * DM, 0, 1.0f, WSC8, rot); rot += 37;
        for (int n = 0; n < 3; ++n) { cvt_matrix(X, p.w_branch + ((size_t)l * 3 + n) * 1024 * DM, 1024, DM, (bf16_t*)(ws + WS_WBR) + ((size_t)l * 3 + n) * DM * 1024, 1024, 0, 0, nullptr, 0, 1.0f, rot); rot += 37; }
        cvt_matrix(X, p.w_mix + (size_t)l * DM * DM, DM, DM, (bf16_t*)(ws + WS_WMIX) + (size_t)l * DM * DM, DM, 0, 0, nullptr, 0, 1.0f, rot); rot += 37;
        cvt_matrix(X, p.w_xq + (size_t)l * DM * 512, DM, 512, (bf16_t*)(ws + WS_WXQ) + (size_t)l * 512 * DM, DM, 0, 0, p.g_pre_x + l * DM, 0, 1.0f, rot); rot += 37;
        cvt_matrix(X, p.w_xkv + (size_t)l * DM * 1024, DM, 1024, (bf16_t*)(ws + WS_WXKV), DM, l * 1024, 0, p.g_mem + l * DM, 0, 1.0f, rot); rot += 37;
        cvt_matrix(X, p.w_xo + (size_t)l * 512 * DM, 512, DM, (bf16_t*)(ws + WS_WXO) + (size_t)l * DM * 512, 512, 0, 0, nullptr, 0, 1.0f, rot); rot += 37;
    }
    if (FFN_GU_FP8) cvt_gateup8(X, p.w_fg, p.w_fu, ws + WS_WGU, p.g_pre_ffn, WSC8, rot);
    else cvt_gateup(X, p.w_fg, p.w_fu, (bf16_t*)(ws + WS_WGU), p.g_pre_ffn, rot);
    rot += 37;
    cvt_matrix8(X, p.w_fd, DFF, DM, ws + WS_WDN, DFF, nullptr, WSC8, rot); rot += 37;
    for (int e = 0; e < NEXP; ++e) {
        { Ctx X3 = X; if (cvt_deferred(X.G) && e >= NEXP - 2) X3.it0 = CVT_DEFER_ITEMS;
          cvt_gateup8(X3, p.w_eg + (size_t)e * DM * DFF, p.w_eu + (size_t)e * DM * DFF, ws + WS_WEGU + (size_t)e * 14336 * DM, p.g_pre_ffn + DM, WSC8, rot); }
        rot += 37;
        cvt_matrix8(X, p.w_ed + (size_t)e * DFF * DM, DFF, DM, ws + WS_WEDN + (size_t)e * DM * DFF, DFF, nullptr, WSC8, rot); rot += 37;
    }
    if (X.dry) return;
    { float* cs = (float*)(ws + WS_ROPE); float* sn = cs + (size_t)S * 64;
      for (int i = X.c * 512 + tid; i < S * 64; i += X.G * 512) { const int pos = i >> 6, k = i & 63;
          const float inv = exp2f(-(float)k * (13.287712379549449f / 64.0f)); const float ang = (float)pos * inv; float sv, cv; sincosf(ang, &sv, &cv); cs[i] = cv; sn[i] = sv; } }
    for (int m = gw; m < MEM_LEN; m += NGW) row_rmsnorm_to_bf16(p.mem + (size_t)m * DM, (bf16_t*)(ws + WS_MEMN) + (size_t)m * DM, lane);
    for (int m = gw; m < S; m += NGW) row_rmsnorm_to_bf16(p.x + (size_t)m * DM, (bf16_t*)(ws + WS_H) + (size_t)m * DM, lane, ws + WS_H8 + (size_t)m * DM);
}

constexpr int XBP = 2 * DM;
struct RouteRec { int e1, e2; float g1, g2; int s1, s2, pad0, pad1; };
template <int MODE, bool ROUTE, bool LAST, bool XS, bool XD>
__device__ __forceinline__ void phase_norm(const Ctx& X, const float* xsrc, float* xdst, const bf16_t* Y, const float* gpost, bf16_t* H,
                                           const float* w_router, const float* gpre, RouteRec* rr, int* hist, unsigned char* H8 = nullptr) {
    TID_INIT();
    LAS float* wr_l = (LAS float*)X.lds;
    LAS int* cnt_l = (LAS int*)(X.lds + 65536);
    if (ROUTE) {
        for (int i = tid; i < DM * NEXP; i += 512) wr_l[i] = w_router[i] * gpre[i >> 3];
        if (tid < 8) cnt_l[tid] = 0;
        __syncthreads();
    }
    const int rstep = X.G, rend = S;
    f32x4 Ax[8], Bx[8]; u32x2 Axb[8], Bxb[8]; u32x2 Ay1[8], By1[8], Ay2[8], By2[8]; float Ag1 = 0.f, Ag2 = 0.f, Bg1 = 0.f, Bg2 = 0.f;
#define NLOAD(R, row_) do { const int r_ = (row_); const bf16_t* y1_ = Y + (size_t)r_ * DM; const bf16_t* y2_ = Y; \
        if (MODE == 1) { const RouteRec q_ = rr[r_]; R##g1 = q_.g1; R##g2 = q_.g2; y1_ = Y + (size_t)q_.s1 * DM; y2_ = Y + (size_t)q_.s2 * DM; } \
        _Pragma("unroll") for (int j = 0; j < 8; ++j) { if (XS) R##xb[j] = *(const u32x2*)((const bf16_t*)xsrc + (size_t)r_ * XBP + j * 256 + lane * 4); else R##x[j] = *(const f32x4*)(xsrc + (size_t)r_ * DM + j * 256 + lane * 4); R##y1[j] = *(const u32x2*)(y1_ + j * 256 + lane * 4); \
            if (MODE == 1) R##y2[j] = *(const u32x2*)(y2_ + j * 256 + lane * 4); } \
        asm volatile("" ::: "memory"); } while (0)
#define NPROC(R, row_) do { const int rw_ = (row_); f32x4 yv[8]; float s = 0.f; \
        _Pragma("unroll") for (int j = 0; j < 8; ++j) { yv[j] = (f32x4){bf2f(R##y1[j].x & 0xffffu), bf2f(R##y1[j].x >> 16), bf2f(R##y1[j].y & 0xffffu), bf2f(R##y1[j].y >> 16)}; \
            if (MODE == 1) yv[j] = yv[j] * R##g1 + (f32x4){bf2f(R##y2[j].x & 0xffffu), bf2f(R##y2[j].x >> 16), bf2f(R##y2[j].y & 0xffffu), bf2f(R##y2[j].y >> 16)} * R##g2; \
            s += (yv[j][0] * yv[j][0] + yv[j][1] * yv[j][1]) + (yv[j][2] * yv[j][2] + yv[j][3] * yv[j][3]); } \
        const float rstd = 1.0f / sqrtf(wave_sum(s) * (1.0f / DM) + EPS); float s2 = 0.f; \
        _Pragma("unroll") for (int j = 0; j < 8; ++j) { const f32x4 g = *(const f32x4*)(gpost + j * 256 + lane * 4); if (XS) R##x[j] = (f32x4){bf2f(R##xb[j].x & 0xffffu), bf2f(R##xb[j].x >> 16), bf2f(R##xb[j].y & 0xffffu), bf2f(R##xb[j].y >> 16)}; \
            R##x[j] = R##x[j] + yv[j] * rstd * g; \
            if (XD) { u32x2 w_; w_.x = pk2(R##x[j][0], R##x[j][1]); w_.y = pk2(R##x[j][2], R##x[j][3]); *(u32x2*)((bf16_t*)xdst + (size_t)rw_ * XBP + j * 256 + lane * 4) = w_; } \
            else *(f32x4*)(xdst + (size_t)rw_ * DM + j * 256 + lane * 4) = R##x[j]; \
            s2 += (R##x[j][0] * R##x[j][0] + R##x[j][1] * R##x[j][1]) + (R##x[j][2] * R##x[j][2] + R##x[j][3] * R##x[j][3]); } \
        if (!LAST) { const float rstd2 = 1.0f / sqrtf(wave_sum(s2) * (1.0f / DM) + EPS); \
            _Pragma("unroll") for (int j = 0; j < 8; ++j) { R##x[j] = R##x[j] * rstd2; \
                if (ROUTE) { *(unsigned*)((unsigned char*)H + (size_t)rw_ * DM + j * 256 + lane * 4) = pk4_fp8(R##x[j][0], R##x[j][1], R##x[j][2], R##x[j][3]); } \
                else { if (H) { u32x2 w; w.x = pk2(R##x[j][0], R##x[j][1]); w.y = pk2(R##x[j][2], R##x[j][3]); *(u32x2*)(H + (size_t)rw_ * DM + j * 256 + lane * 4) = w; } \
                    if (H8) *(unsigned*)(H8 + (size_t)rw_ * DM + j * 256 + lane * 4) = pk4_fp8(R##x[j][0], R##x[j][1], R##x[j][2], R##x[j][3]); } } \
            if (ROUTE) { float lg[8] = {0.f, 0.f, 0.f, 0.f, 0.f, 0.f, 0.f, 0.f}; \
                _Pragma("unroll") for (int j = 0; j < 8; ++j) _Pragma("unroll") for (int q = 0; q < 4; ++q) { const int k = j * 256 + lane * 4 + q; \
                    const f32x4 a = *(const LAS f32x4*)(wr_l + k * 8), b = *(const LAS f32x4*)(wr_l + k * 8 + 4); const float xx = R##x[j][q]; \
                    lg[0] += xx * a[0]; lg[1] += xx * a[1]; lg[2] += xx * a[2]; lg[3] += xx * a[3]; lg[4] += xx * b[0]; lg[5] += xx * b[1]; lg[6] += xx * b[2]; lg[7] += xx * b[3]; } \
                _Pragma("unroll") for (int e = 0; e < 8; ++e) lg[e] = wave_sum(lg[e]); \
                int e1 = 0; float v1 = lg[0]; \
                _Pragma("unroll") for (int e = 1; e < 8; ++e) if (lg[e] > v1) { v1 = lg[e]; e1 = e; } \
                int e2 = -1; float v2 = -__builtin_inff(); \
                _Pragma("unroll") for (int e = 0; e < 8; ++e) if (e != e1 && lg[e] > v2) { v2 = lg[e]; e2 = e; } \
                const float ex = __expf(v2 - v1); const float ga = 1.0f / (1.0f + ex), gb = ex / (1.0f + ex); \
                if (lane == 0) { RouteRec r; r.e1 = e1; r.e2 = e2; r.g1 = ga; r.g2 = gb; r.s1 = 0; r.s2 = 0; r.pad0 = 0; r.pad1 = 0; rr[rw_] = r; atomicAdd((int*)cnt_l + e1, 1); atomicAdd((int*)cnt_l + e2, 1); } } } \
        } while (0)
    int row = X.c + rstep * wave;
    if (row < rend) NLOAD(A, row);
    for (; row < rend; row += 16 * rstep) {
        if (row + 8 * rstep < rend) NLOAD(B, row + 8 * rstep);
        NPROC(A, row);
        if (row + 16 * rstep < rend) NLOAD(A, row + 16 * rstep);
        if (row + 8 * rstep < rend) NPROC(B, row + 8 * rstep);
    }
#undef NLOAD
#undef NPROC
    if (ROUTE) { __syncthreads(); if (tid < 8) hist[X.c * 8 + tid] = cnt_l[tid]; }
}

__device__ __forceinline__ void phase_assign(const Ctx& X, RouteRec* rr, const int* hist, int* tstart_g, int* slottok, const unsigned char* H8, unsigned char* HP8) {
    TID_INIT();
    LAS int* hl = (LAS int*)X.lds;
    LAS int* base_l = hl + 4096;
    LAS int* seg_l = base_l + 8;
    LAS int* slot_l = seg_l + 32;
    LAS int* ex_l = slot_l + 1024;
    const int rpw = (S + X.G - 1) / X.G;
    for (int i = tid; i < X.G * 8; i += 512) hl[i] = hist[i];
    for (int ri = tid; ri < rpw; ri += 512) { const int row = X.c + X.G * ri; int e1 = -1, e2 = -1; if (row < S) { e1 = rr[row].e1; e2 = rr[row].e2; } ex_l[ri * 2] = e1; ex_l[ri * 2 + 1] = e2; }
    __syncthreads();
    if (tid < 8) { int tot = 0, before = 0; for (int c = 0; c < X.G; ++c) { const int v = hl[c * 8 + tid]; if (c < X.c) before += v; tot += v; } seg_l[16 + tid] = tot; base_l[tid] = before; }
    __syncthreads();
    if (tid == 0) { int t = 0; for (int e = 0; e < 8; ++e) { seg_l[e] = t * 256; if (X.c == 0) tstart_g[e] = t; t += (seg_l[16 + e] + 255) >> 8; } seg_l[8] = t * 256; if (X.c == 0) tstart_g[8] = t; }
    __syncthreads();
    if (tid < 8) { const int e = tid; int pos = seg_l[e] + base_l[e];
        for (int ri = 0; ri < rpw; ++ri) { if (ex_l[ri * 2] == e) { slot_l[ri * 2] = pos; ++pos; } if (ex_l[ri * 2 + 1] == e) { slot_l[ri * 2 + 1] = pos; ++pos; } } }
    if (X.c < 8) { const int e = X.c; const int lo = seg_l[e] + seg_l[16 + e], hi = seg_l[e + 1]; for (int i = lo + tid; i < hi; i += 512) slottok[i] = 0; }
    __syncthreads();
    for (int ri = tid; ri < rpw; ri += 512) { const int row = X.c + X.G * ri; if (row < S) { const int s1 = slot_l[ri * 2], s2 = slot_l[ri * 2 + 1]; rr[row].s1 = s1; rr[row].s2 = s2; slottok[s1] = row; slottok[s2] = row; } }
    for (int ri = wave; ri < rpw; ri += 8) { const int row = X.c + X.G * ri; if (row >= S) break;
        const u32x4 a = *(const u32x4*)(H8 + (size_t)row * DM + lane * 32), b = *(const u32x4*)(H8 + (size_t)row * DM + lane * 32 + 16);
        const int s1 = slot_l[ri * 2], s2 = slot_l[ri * 2 + 1];
        *(u32x4*)(HP8 + (size_t)s1 * DM + lane * 32) = a; *(u32x4*)(HP8 + (size_t)s1 * DM + lane * 32 + 16) = b;
        *(u32x4*)(HP8 + (size_t)s2 * DM + lane * 32) = a; *(u32x4*)(HP8 + (size_t)s2 * DM + lane * 32 + 16) = b; }
}

constexpr int TAIL_MAX = 64;
__device__ __forceinline__ int moe_tail_units(const int* tstart, int G) { const int nun = tstart[8] * (DM / 256); int T = nun % G; if (!ONE_LAUNCH || T > TAIL_MAX) T = 0; return T; }
__device__ __forceinline__ void phase_tailfix(const Ctx& X, const int* tstart, const bf16_t* YP, bf16_t* YS) {
    TID_INIT();
    const int T = moe_tail_units(tstart, X.G); if (T == 0) return;
    pg8::MoeOrder<false> mo; mo.init(tstart, DM, X.G, X.c, nullptr); const int first = mo.nwg - T;
    for (int g = X.c * 512 + tid; g < T * 8192; g += X.G * 512) { const int j = g >> 13, r = (g >> 5) & 255, c8 = g & 31; pg8::Unit u; mo.unit_of(first + j, u);
        float a[8] = {0.f, 0.f, 0.f, 0.f, 0.f, 0.f, 0.f, 0.f};
#pragma unroll
        for (int ks = 0; ks < pg8::MoeTailOrder::NSL; ++ks) { const u32x4 w = *(const u32x4*)(YP + ((size_t)(j * pg8::MoeTailOrder::NSL + ks) << 16) + r * 256 + c8 * 8);
            a[0] += bf2f(w.x & 0xffffu); a[1] += bf2f(w.x >> 16); a[2] += bf2f(w.y & 0xffffu); a[3] += bf2f(w.y >> 16); a[4] += bf2f(w.z & 0xffffu); a[5] += bf2f(w.z >> 16); a[6] += bf2f(w.w & 0xffffu); a[7] += bf2f(w.w >> 16); }
        u32x4 o; o.x = pk2(a[0], a[1]); o.y = pk2(a[2], a[3]); o.z = pk2(a[4], a[5]); o.w = pk2(a[6], a[7]);
        *(u32x4*)(YS + (size_t)(u.pm * 256 + r) * DM + u.pn * 256 + c8 * 8) = o; }
}

__device__ __forceinline__ void unpack8(const u32x4 w, float (&f)[8]) {
    f[0] = bf2f(w.x & 0xffffu); f[1] = bf2f(w.x >> 16); f[2] = bf2f(w.y & 0xffffu); f[3] = bf2f(w.y >> 16);
    f[4] = bf2f(w.z & 0xffffu); f[5] = bf2f(w.z >> 16); f[6] = bf2f(w.w & 0xffffu); f[7] = bf2f(w.w >> 16);
}
__device__ __forceinline__ void phase_conv(const Ctx& X, const bf16_t* P, const float* wconv, bf16_t* Y3) {
    TID_INIT();
    for (int it = X.c * 512 + tid; it < (S / 4) * 128; it += X.G * 512) { const int oct = it & 31, tl = (it >> 5) & 3, t0 = (it >> 7) * 4, w0 = tl * 256 + oct * 8;
        const bf16_t* pc = P + pidx(0, C_CC + w0); const bf16_t* pu = P + pidx(0, C_CU + w0); const bf16_t* pb = P + pidx(0, C_CB + w0);
        u32x4 cr[6], ur[6], br[4];
#pragma unroll
        for (int j = 0; j < 6; ++j) { const int tt = t0 - 2 + j, tc = tt < 0 ? 0 : tt; cr[j] = *(const u32x4*)(pc + (size_t)tc * 256); ur[j] = *(const u32x4*)(pu + (size_t)tc * 256); }
#pragma unroll
        for (int j = 0; j < 4; ++j) br[j] = *(const u32x4*)(pb + (size_t)(t0 + j) * 256);
        float wv[3][8];
#pragma unroll
        for (int j = 0; j < 3; ++j) { const f32x4 wa = *(const f32x4*)(wconv + j * 1024 + w0), wb = *(const f32x4*)(wconv + j * 1024 + w0 + 4);
#pragma unroll
            for (int q = 0; q < 4; ++q) { wv[j][q] = wa[q]; wv[j][4 + q] = wb[q]; } }
        float v[6][8];
#pragma unroll
        for (int j = 0; j < 6; ++j) { float c[8], u[8]; unpack8(cr[j], c); unpack8(ur[j], u); const float msk = (t0 - 2 + j) < 0 ? 0.f : 1.f;
#pragma unroll
            for (int q = 0; q < 8; ++q) v[j][q] = c[q] * u[q] * msk; }
#pragma unroll
        for (int j = 0; j < 4; ++j) { float bb[8]; unpack8(br[j], bb); float r[8];
#pragma unroll
            for (int q = 0; q < 8; ++q) r[q] = bb[q] * (wv[0][q] * v[j][q] + wv[1][q] * v[j + 1][q] + wv[2][q] * v[j + 2][q]);
            u32x4 o; o.x = pk2(r[0], r[1]); o.y = pk2(r[2], r[3]); o.z = pk2(r[4], r[5]); o.w = pk2(r[6], r[7]);
            *(u32x4*)(Y3 + (size_t)S * 1024 + (size_t)(t0 + j) * 1024 + w0) = o; } }
}

__device__ __forceinline__ int tr_addr(int lane, int pitch) { const int g = lane >> 4, i = lane & 15; return ((g >> 1) * 8 + (i >> 2)) * pitch + ((g & 1) * 16 + (i & 3) * 4) * 2; }
#define TR_READ2(lo, hi, addr, off_lo, off_hi) do { asm volatile("ds_read_b64_tr_b16 %0, %1 offset:%2" : "=&v"(lo) : "v"(addr), "i"(off_lo) : "memory"); \
                                                     asm volatile("ds_read_b64_tr_b16 %0, %1 offset:%2" : "=&v"(hi) : "v"(addr), "i"(off_hi) : "memory"); } while (0)
constexpr int RP_T = 320;
constexpr int RP_R = 272;
__device__ __forceinline__ float ret_logg(int h) { return log1pf(-exp2f(-5.0f - (float)h)); }
__device__ __forceinline__ void rope8(const u32x4 w1, const u32x4 w2, const float* cs, const float* sn, float scale, u32x4& o1, u32x4& o2) {
    float a[8], b[8]; unpack8(w1, a); unpack8(w2, b);
    const f32x4 c0 = *(const f32x4*)cs, c1 = *(const f32x4*)(cs + 4), s0 = *(const f32x4*)sn, s1 = *(const f32x4*)(sn + 4);
    float r1[8], r2[8];
#pragma unroll
    for (int q = 0; q < 4; ++q) { r1[q] = (a[q] * c0[q] - b[q] * s0[q]) * scale; r2[q] = (a[q] * s0[q] + b[q] * c0[q]) * scale;
        r1[4 + q] = (a[4 + q] * c1[q] - b[4 + q] * s1[q]) * scale; r2[4 + q] = (a[4 + q] * s1[q] + b[4 + q] * c1[q]) * scale; }
    o1.x = pk2(r1[0], r1[1]); o1.y = pk2(r1[2], r1[3]); o1.z = pk2(r1[4], r1[5]); o1.w = pk2(r1[6], r1[7]);
    o2.x = pk2(r2[0], r2[1]); o2.y = pk2(r2[2], r2[3]); o2.z = pk2(r2[4], r2[5]); o2.w = pk2(r2[6], r2[7]);
}
__device__ __forceinline__ void phase_ret_kv(const Ctx& X, const bf16_t* P, const float* rope_cs, float* KVS) {
    LAS unsigned char* kd_l = X.lds;
    LAS unsigned char* v_l = X.lds + 128 * RP_T;
    TID_INIT();
    const float* rope_sn = rope_cs + (size_t)S * 64;
    const int w = wave, r32 = lane & 31, hi = lane >> 5;
    for (int u = X.c; u < 1024; u += X.G) { const int n = u >> 3, h = u & 7, t0 = n * 128; const float lg = ret_logg(h);
#pragma unroll
        for (int ii = 0; ii < 2; ++ii) { const int pi = tid + 512 * ii, j = pi >> 3, d0 = (pi & 7) * 8; const bf16_t* kp = P + pidx(t0 + j, C_RK + h * 128 + d0);
            u32x4 o1, o2; rope8(*(const u32x4*)kp, *(const u32x4*)(kp + 64), rope_cs + (size_t)(t0 + j) * 64 + d0, rope_sn + (size_t)(t0 + j) * 64 + d0, __expf((float)(127 - j) * lg), o1, o2);
            *(LAS u32x4*)(kd_l + j * RP_T + d0 * 2) = o1; *(LAS u32x4*)(kd_l + j * RP_T + (d0 + 64) * 2) = o2; }
#pragma unroll
        for (int ii = 0; ii < 4; ++ii) { const int pi = tid + 512 * ii, j = pi >> 4, e0 = (pi & 15) * 8;
            *(LAS u32x4*)(v_l + j * RP_T + e0 * 2) = *(const u32x4*)(P + pidx(t0 + j, C_RV + h * 128 + e0)); }
        LDS_WAIT(); __syncthreads();
        const int db = w >> 1, eb0 = (w & 1) * 2;
        f32x16 c0 = {}, c1 = {};
        const int ta = (int)(uintptr_t)(kd_l) + tr_addr(lane, RP_T) + db * 64, tb = (int)(uintptr_t)(v_l) + tr_addr(lane, RP_T) + eb0 * 64;
#define RKV_STEP(ks) do { s16x4 al, ah, bl0, bh0, bl1, bh1; \
            TR_READ2(al, ah, ta, (ks) * 16 * RP_T, (ks) * 16 * RP_T + 4 * RP_T); TR_READ2(bl0, bh0, tb, (ks) * 16 * RP_T, (ks) * 16 * RP_T + 4 * RP_T); TR_READ2(bl1, bh1, tb, (ks) * 16 * RP_T + 64, (ks) * 16 * RP_T + 4 * RP_T + 64); \
            LDS_WAIT(); __builtin_amdgcn_sched_barrier(0); \
            const bf16x8 af = {al[0], al[1], al[2], al[3], ah[0], ah[1], ah[2], ah[3]}; \
            c0 = __builtin_amdgcn_mfma_f32_32x32x16_bf16(af, (bf16x8){bl0[0], bl0[1], bl0[2], bl0[3], bh0[0], bh0[1], bh0[2], bh0[3]}, c0, 0, 0, 0); \
            c1 = __builtin_amdgcn_mfma_f32_32x32x16_bf16(af, (bf16x8){bl1[0], bl1[1], bl1[2], bl1[3], bh1[0], bh1[1], bh1[2], bh1[3]}, c1, 0, 0, 0); } while (0)
        RKV_STEP(0); RKV_STEP(1); RKV_STEP(2); RKV_STEP(3); RKV_STEP(4); RKV_STEP(5); RKV_STEP(6); RKV_STEP(7);
#undef RKV_STEP
        float* outp = KVS + (size_t)u * 16384;
#pragma unroll
        for (int r = 0; r < 16; ++r) { const int d = db * 32 + att::crow(r, hi); outp[d * 128 + eb0 * 32 + r32] = c0[r]; outp[d * 128 + (eb0 + 1) * 32 + r32] = c1[r]; }
        __syncthreads();
    }
}
__device__ __forceinline__ void phase_ret_scan(const Ctx& X, const float* KVS, bf16_t* PRV) {
    TID_INIT();
    for (int idx = X.c * 512 + tid; idx < 8 * 16384; idx += X.G * 512) { const int h = idx >> 14, ed = idx & 16383; const float cd = __expf(128.0f * ret_logg(h));
        float st = 0.f;
        for (int n0 = 0; n0 < 128; n0 += 16) { float kv[16];
#pragma unroll
            for (int q = 0; q < 16; ++q) kv[q] = KVS[((size_t)((n0 + q) * 8 + h) << 14) + ed];
#pragma unroll
            for (int q = 0; q < 16; ++q) { PRV[((size_t)((n0 + q) * 8 + h) << 14) + ed] = (bf16_t)f2bf(st); st = st * cd + kv[q]; } } }
}
__device__ __forceinline__ void phase_ret_out(const Ctx& X, const bf16_t* P, const float* rope_cs, const bf16_t* PRV, bf16_t* Y3) {
    LAS unsigned char* q_l = X.lds;
    LAS unsigned char* k_l = X.lds + 128 * RP_R;
    LAS unsigned char* v_l = X.lds + 2 * 128 * RP_R;
    LAS unsigned char* s_l = v_l + 128 * RP_T;
    LAS float* o_l = (LAS float*)X.lds;
    static_assert(2 * 128 * RP_R + 2 * 128 * RP_T <= LDS_CTL_OFF && 128 * 132 * 4 <= 2 * 128 * RP_R, "retention LDS map");
    TID_INIT();
    const float* rope_sn = rope_cs + (size_t)S * 64;
    const int w = wave, r32 = lane & 31, hi = lane >> 5;
    for (int u = X.c; u < 1024; u += X.G) { const int n = u >> 3, h = u & 7, t0 = n * 128; const float lg = ret_logg(h);
#pragma unroll
        for (int ii = 0; ii < 2; ++ii) { const int pi = tid + 512 * ii, j = pi >> 3, d0 = (pi & 7) * 8; const size_t ro = pidx(t0 + j, h * 128 + d0);
            const float* cs = rope_cs + (size_t)(t0 + j) * 64 + d0; const float* sn = rope_sn + (size_t)(t0 + j) * 64 + d0; u32x4 o1, o2;
            rope8(*(const u32x4*)(P + ro + C_RQ), *(const u32x4*)(P + ro + C_RQ + 64), cs, sn, 1.0f, o1, o2);
            *(LAS u32x4*)(q_l + j * RP_R + d0 * 2) = o1; *(LAS u32x4*)(q_l + j * RP_R + (d0 + 64) * 2) = o2;
            rope8(*(const u32x4*)(P + ro + (size_t)4 * S * 256), *(const u32x4*)(P + ro + (size_t)4 * S * 256 + 64), cs, sn, 1.0f, o1, o2);
            *(LAS u32x4*)(k_l + j * RP_R + d0 * 2) = o1; *(LAS u32x4*)(k_l + j * RP_R + (d0 + 64) * 2) = o2; }
#pragma unroll
        for (int ii = 0; ii < 4; ++ii) { const int pi = tid + 512 * ii, j = pi >> 4, e0 = (pi & 15) * 8;
            *(LAS u32x4*)(v_l + j * RP_T + e0 * 2) = *(const u32x4*)(P + pidx(t0 + j, C_RV + h * 128 + e0));
            *(LAS u32x4*)(s_l + j * RP_T + e0 * 2) = *(const u32x4*)(PRV + (size_t)u * 16384 + j * 128 + e0); }
        LDS_WAIT(); __syncthreads();
        const int ib = w >> 1, jb0 = (w & 1) * 2;
        f32x16 s0 = {}, s1 = {};
#pragma unroll
        for (int ks = 0; ks < 8; ++ks) { const bf16x8 a = *(const LAS bf16x8*)(q_l + (ib * 32 + r32) * RP_R + (ks * 16 + hi * 8) * 2);
            const bf16x8 b0 = *(const LAS bf16x8*)(k_l + (jb0 * 32 + r32) * RP_R + (ks * 16 + hi * 8) * 2), b1 = *(const LAS bf16x8*)(k_l + ((jb0 + 1) * 32 + r32) * RP_R + (ks * 16 + hi * 8) * 2);
            s0 = __builtin_amdgcn_mfma_f32_32x32x16_bf16(a, b0, s0, 0, 0, 0); s1 = __builtin_amdgcn_mfma_f32_32x32x16_bf16(a, b1, s1, 0, 0, 0); }
        __syncthreads();
#pragma unroll
        for (int r = 0; r < 16; ++r) { const int i = ib * 32 + att::crow(r, hi); const int j0 = jb0 * 32 + r32, j1 = j0 + 32;
            const float p0 = (i >= j0) ? s0[r] * __expf((float)(i - j0) * lg) : 0.f, p1 = (i >= j1) ? s1[r] * __expf((float)(i - j1) * lg) : 0.f;
            *(LAS bf16_t*)(k_l + i * RP_R + j0 * 2) = (bf16_t)f2bf(p0); *(LAS bf16_t*)(k_l + i * RP_R + j1 * 2) = (bf16_t)f2bf(p1); }
        LDS_WAIT(); __syncthreads();
        const int eb0 = (w & 1) * 2;
        f32x16 a0 = {}, a1 = {}, x0 = {}, x1 = {};
        const int tv = (int)(uintptr_t)(v_l) + tr_addr(lane, RP_T) + eb0 * 64, tsx = (int)(uintptr_t)(s_l) + tr_addr(lane, RP_T) + eb0 * 64;
#define ROUT_STEP(ks) do { s16x4 bl0, bh0, bl1, bh1, cl0, ch0, cl1, ch1; \
            TR_READ2(bl0, bh0, tv, (ks) * 16 * RP_T, (ks) * 16 * RP_T + 4 * RP_T); TR_READ2(bl1, bh1, tv, (ks) * 16 * RP_T + 64, (ks) * 16 * RP_T + 4 * RP_T + 64); \
            TR_READ2(cl0, ch0, tsx, (ks) * 16 * RP_T, (ks) * 16 * RP_T + 4 * RP_T); TR_READ2(cl1, ch1, tsx, (ks) * 16 * RP_T + 64, (ks) * 16 * RP_T + 4 * RP_T + 64); \
            const bf16x8 pa = *(const LAS bf16x8*)(k_l + (ib * 32 + r32) * RP_R + ((ks) * 16 + hi * 8) * 2), qa = *(const LAS bf16x8*)(q_l + (ib * 32 + r32) * RP_R + ((ks) * 16 + hi * 8) * 2); \
            LDS_WAIT(); __builtin_amdgcn_sched_barrier(0); \
            a0 = __builtin_amdgcn_mfma_f32_32x32x16_bf16(pa, (bf16x8){bl0[0], bl0[1], bl0[2], bl0[3], bh0[0], bh0[1], bh0[2], bh0[3]}, a0, 0, 0, 0); \
            a1 = __builtin_amdgcn_mfma_f32_32x32x16_bf16(pa, (bf16x8){bl1[0], bl1[1], bl1[2], bl1[3], bh1[0], bh1[1], bh1[2], bh1[3]}, a1, 0, 0, 0); \
            x0 = __builtin_amdgcn_mfma_f32_32x32x16_bf16(qa, (bf16x8){cl0[0], cl0[1], cl0[2], cl0[3], ch0[0], ch0[1], ch0[2], ch0[3]}, x0, 0, 0, 0); \
            x1 = __builtin_amdgcn_mfma_f32_32x32x16_bf16(qa, (bf16x8){cl1[0], cl1[1], cl1[2], cl1[3], ch1[0], ch1[1], ch1[2], ch1[3]}, x1, 0, 0, 0); } while (0)
        ROUT_STEP(0); ROUT_STEP(1); ROUT_STEP(2); ROUT_STEP(3); ROUT_STEP(4); ROUT_STEP(5); ROUT_STEP(6); ROUT_STEP(7);
#undef ROUT_STEP
        __syncthreads();
#pragma unroll
        for (int r = 0; r < 16; ++r) { const int i = ib * 32 + att::crow(r, hi); const float qd = __expf((float)(i + 1) * lg);
            o_l[i * 132 + eb0 * 32 + r32] = a0[r] + qd * x0[r]; o_l[i * 132 + (eb0 + 1) * 32 + r32] = a1[r] + qd * x1[r]; }
        LDS_WAIT(); __syncthreads();
        for (int ri = 0; ri < 16; ++ri) { const int i = w * 16 + ri; const f32x2 v = *(const LAS f32x2*)(o_l + i * 132 + lane * 2);
            const float rstd = 1.0f / sqrtf(wave_sum(v[0] * v[0] + v[1] * v[1]) * (1.0f / 128.0f) + EPS);
            const unsigned gw = *(const unsigned*)(P + pidx(t0 + i, C_RG + h * 128 + lane * 2));
            *(unsigned*)(Y3 + (size_t)(t0 + i) * 1024 + h * 128 + lane * 2) = pk2(bf2f(gw & 0xffffu) * v[0] * rstd, bf2f(gw >> 16) * v[1] * rstd); }
        __syncthreads();
    }
}

__device__ __forceinline__ void phase_diff_combine(const Ctx& X, const bf16_t* OT, const float* dlam, const float* dsub, float lam_init, bf16_t* Y3) {
    TID_INIT();
    float d1 = dlam[lane] * dlam[128 + lane] + dlam[64 + lane] * dlam[128 + 64 + lane];
    float d2 = dlam[256 + lane] * dlam[384 + lane] + dlam[256 + 64 + lane] * dlam[384 + 64 + lane];
    const float lam = __expf(wave_sum(d1)) - __expf(wave_sum(d2)) + lam_init;
    const f32x4 sg = *(const f32x4*)(dsub + lane * 4);
    for (int it = gw; it < S * 4; it += NGW) { const int t = it >> 2, h = it & 3;
        const u32x2 w0 = *(const u32x2*)(OT + (size_t)t * 2048 + h * 512 + lane * 4), w1 = *(const u32x2*)(OT + (size_t)t * 2048 + h * 512 + 256 + lane * 4);
        f32x4 o = (f32x4){bf2f(w0.x & 0xffffu), bf2f(w0.x >> 16), bf2f(w0.y & 0xffffu), bf2f(w0.y >> 16)} - (f32x4){bf2f(w1.x & 0xffffu), bf2f(w1.x >> 16), bf2f(w1.y & 0xffffu), bf2f(w1.y >> 16)} * lam;
        const float rstd = 1.0f / sqrtf(wave_sum((o[0] * o[0] + o[1] * o[1]) + (o[2] * o[2] + o[3] * o[3])) * (1.0f / 256.0f) + EPS) * (1.0f - lam_init);
        o = o * rstd * sg; u32x2 w; w.x = pk2(o[0], o[1]); w.y = pk2(o[2], o[3]);
        *(u32x2*)(Y3 + (size_t)2 * S * 1024 + (size_t)t * 1024 + h * 256 + lane * 4) = w; }
}

__device__ __forceinline__ att2::Blk diff_blk(const bf16_t* P, bf16_t* OT, const float* bias_l, int L, int pass) {
    const int hm = (L & 7), x = (L >> 3) & 63, qb = pass ? 127 - x : x; const int h = hm >> 1, m = hm & 1;
    att2::Blk r;
    r.Q = P + pidx(qb * 128, C_DQ + h * 256 + m * 128); r.K = P + pidx(0, C_DK + h * 256 + m * 128); r.V = P + pidx(0, C_DV + h * 256);
    r.O = OT + (size_t)qb * 128 * 2048 + h * 512 + m * 256; r.P0 = qb * 128; r.btab = bias_l + h * 128; return r;
}
__device__ __forceinline__ void phase_diff_attn(const Ctx& X, const bf16_t* P, bf16_t* OT, const float* t5) {
    TID_INIT();
    char* lds = (char*)X.lds; float* bias_l = (float*)(lds + att2::OFF_BIAS);
    { const int h = tid >> 7, d = tid & 127; int b = d; if (d >= 16) { b = 16 + (int)(logf((float)d * (1.0f / 16.0f)) / logf(8.0f) * 16.0f); if (b > 31) b = 31; }
      bias_l[h * 128 + d] = (t5[b * 4 + h] - t5[31 * 4 + h]) * (1.0f / att::SCALE); }
    __syncthreads();
    for (int L = X.c; L < 512; L += X.G) {
        { const att2::Blk b1 = diff_blk(P, OT, bias_l, L, 1); att2::attn_block(b1, lds, X.lds, X.wv, L != X.c, true); }
        { const att2::Blk b0 = diff_blk(P, OT, bias_l, L, 0); att2::attn_block(b0, lds, X.lds, X.wv, true, L + X.G < 512); }
    }
}
__device__ __forceinline__ att::BlockRef xattn_ref(const bf16_t* QX, const bf16_t* KVX, bf16_t* OX, int l, int L) {
    const int h = L & 3, qb = L >> 2; att::BlockRef r;
    r.Q = QX + (size_t)qb * 256 * 512 + h * 128; r.K = KVX + l * 1024 + h * 128; r.V = KVX + l * 1024 + 512 + h * 128; r.O = OX + (size_t)qb * 256 * 512 + h * 128; r.P0 = 1 << 20; r.btab = nullptr; return r;
}
__device__ __forceinline__ void phase_xattn(const Ctx& X, const bf16_t* QX, const bf16_t* KVX, bf16_t* OX, int l) {
    char* lds = (char*)X.lds; typedef att::Pitch<512, 2048, 512> PT;
    int L = X.c; if (L >= 256) return;
    att::BlockRef cur = xattn_ref(QX, KVX, OX, l, L); att::Seam Sm;
    att::attn_prime<PT>(cur, att::WBIG, lds, Sm, X.wv);
    for (;;) {
        const bool last = L + X.G >= 256; const int Ln = last ? L : L + X.G;
        const att::BlockRef nxt = last ? cur : xattn_ref(QX, KVX, OX, l, Ln);
        att::attn_block<false, PT>(cur, nxt, MEM_LEN, att::WBIG, lds, Sm, X.wv);
        if (last) break;
        cur = nxt; L = Ln;
    }
}

constexpr int PH_PER_LAYER = 15, N_PHASES = 1 + DEPTH * PH_PER_LAYER;
#define PHB const Params& p = p_kernarg; unsigned char* const ws = p.ws; Ctx X; X.G = gridDim.x; X.c = blockIdx.x; X.wv = wv; X.dry = 0; X.lds = smem; X.ws = ws; \
    bf16_t* const P = (bf16_t*)(ws + WS_P); bf16_t* const H = (bf16_t*)(ws + WS_H); bf16_t* const Y = (bf16_t*)(ws + WS_Y); bf16_t* const Y3 = (bf16_t*)(ws + WS_Y3); \
    bf16_t* const OT = (bf16_t*)(ws + WS_OT); bf16_t* const MG = (bf16_t*)(ws + WS_MG); bf16_t* const QX = (bf16_t*)(ws + WS_QX); bf16_t* const OX = (bf16_t*)(ws + WS_OX); \
    bf16_t* const YS = (bf16_t*)(ws + WS_YS); bf16_t* const YP = (bf16_t*)(ws + WS_P + 256 * MiB); (void)YP; float* const KVS = (float*)(ws + WS_KVS); bf16_t* const PRV = (bf16_t*)(ws + WS_PRV); \
    bf16_t* const KVX = (bf16_t*)(ws + WS_KVX); const float* const ROPE = (const float*)(ws + WS_ROPE); \
    RouteRec* const RR = (RouteRec*)(ws + WS_ROUTE); int* const SLOTTOK = (int*)(ws + WS_SLOTTOK); int* const HIST = (int*)(ws + WS_HIST); int* const TSTART = HIST + 4096; \
    (void)P; (void)H; (void)Y; (void)Y3; (void)OT; (void)MG; (void)QX; (void)OX; (void)YS; (void)KVS; (void)PRV; (void)KVX; (void)ROPE; (void)RR; (void)SLOTTOK; (void)HIST; (void)TSTART; (void)X
#if ONE_LAUNCH
#define IN0 true
#define IN(j) true
#ifndef PROBE_BAR
#define PROBE_BAR 1
#endif
#define SEAM() do { XcdBarrier bar_; bar_.bar = (unsigned*)(p_kernarg.ws + WS_CTL); bar_.x = xb_xcc_id(); bar_.st = ctl_l; bar_.wv = wv; for (int rb_ = 0; rb_ < PROBE_BAR; ++rb_) xcd_barrier(bar_); } while (0)
#else
#define IN0 (slot == 15)
#define IN(j) (slot == (j))
#define SEAM() do { } while (0)
#endif
#ifndef PROBE_MASK
#define PROBE_MASK 0x0
#endif
#ifndef PROBE_LAYER
#define PROBE_LAYER -1
#endif
#ifndef PROBE_NORM
#define PROBE_NORM 0x0
#endif
#define NPROBE(j) ((((PROBE_NORM) >> (j)) & 1) && (PROBE_LAYER < 0 || PROBE_LAYER == l))
#define XDUMMY ((float*)(ws + WS_Y3))
#ifndef PROBE_REPS
#define PROBE_REPS 2
#endif
#define REP(j) for (int rep_ = 0; rep_ < (((((PROBE_MASK) >> (j)) & 1) && (PROBE_LAYER < 0 || PROBE_LAYER == l)) ? PROBE_REPS : 1); ++rep_)
__device__ __forceinline__ void layer_body(const int l, const int slot, const Params& p_kernarg, LAS unsigned char* smem, volatile LAS unsigned* ctl_l, const int wv) {
    (void)slot; (void)ctl_l;
        REP(0) if (IN(0)) { PHB;
            { pg8::Gemm g{H, (const bf16_t*)(ws + WS_WIN) + (size_t)l * NIN16 * DM, S, NIN16, DM, 0, 0}; pg8::StaticOrder So; So.init(S, NIN16, X.G, X.c);
              pg8::EpiStore<1> E{P, NIN, 1.0f}; pg8::gemm_phase(X.lds, g, So, E, X.wv); }
            { pg8::Gemm g{(const bf16_t*)(ws + WS_H8), (const bf16_t*)(ws + WS_WIN8 + (size_t)l * NIN8 * DM), S, NIN8, DM / 2, 0, 0}; pg8::StaticOrder So; So.init(S, NIN8, X.G, X.c);
              pg8::EpiStore<2> E{P, NIN, 1.0f / WSC8}; pg8::gemm_phase<pg8::EpiStore<2>, pg8::StaticOrder, true>(X.lds, g, So, E, X.wv); }
        }
        SEAM();
        REP(1) if (IN(1)) { PHB;
            phase_ret_kv(X, P, ROPE, KVS);
            phase_conv(X, P, p.w_conv + l * 3 * 1024, Y3);
            __syncthreads();
            phase_diff_attn(X, P, OT, p.t5);
        }
        SEAM();
        REP(2) if (IN(2)) { PHB;
            phase_ret_scan(X, KVS, PRV);
            phase_diff_combine(X, OT, p.dlam + l * 512, p.dsub + l * 256, 0.8f - 0.6f * __expf(-0.3f * (float)l), Y3);
        }
        SEAM();
        REP(3) if (IN(3)) { PHB; phase_ret_out(X, P, ROPE, PRV, Y3); }
        SEAM();
        REP(4) if (IN(4)) { PHB;
            pg8::Gemm g{Y3, (const bf16_t*)(ws + WS_WBR) + (size_t)l * 3 * DM * 1024, S, DM, 1024, (size_t)DM * 1024 * 2, (size_t)S * 1024 * 2}; pg8::MergeOrder So; So.init(S, DM, X.G, X.c);
            pg8::EpiMerge E{MG, DM, P, NIN}; pg8::gemm_phase(X.lds, g, So, E, X.wv);
        }
        SEAM();
        REP(5) if (IN(5)) { PHB;
            pg8::Gemm g{MG, (const bf16_t*)(ws + WS_WMIX) + (size_t)l * DM * DM, S, DM, DM, 0, 0}; pg8::StaticOrder So; So.init(S, DM, X.G, X.c);
            pg8::EpiStore<0> E{Y, DM, 1.0f}; pg8::gemm_phase(X.lds, g, So, E, X.wv);
        }
        SEAM();
        REP(6) if (IN(6)) { PHB; if (NPROBE(6)) { if (l == 0) phase_norm<0, false, false, false, true>(X, p.x, XDUMMY, Y, p.g_post_mix + l * DM, H, nullptr, nullptr, nullptr, nullptr);
                else phase_norm<0, false, false, true, true>(X, p.out, XDUMMY, Y, p.g_post_mix + l * DM, H, nullptr, nullptr, nullptr, nullptr); __syncthreads(); }
            if (l == 0) phase_norm<0, false, false, false, true>(X, p.x, p.out, Y, p.g_post_mix + l * DM, H, nullptr, nullptr, nullptr, nullptr);
            else phase_norm<0, false, false, true, true>(X, p.out, p.out, Y, p.g_post_mix + l * DM, H, nullptr, nullptr, nullptr, nullptr); }
        SEAM();
        REP(7) if (IN(7)) { PHB;
            if (cvt_deferred(X.G) && X.c >= (l == 0 ? 136 : 128)) { Ctx X2 = X; X2.G = X.G - (l == 0 ? 136 : 128); X2.c = X.c - (l == 0 ? 136 : 128); X2.it1 = CVT_DEFER_ITEMS; const int e = NEXP - 1 - l;
                cvt_gateup8(X2, p.w_eg + (size_t)e * DM * DFF, p.w_eu + (size_t)e * DM * DFF, ws + WS_WEGU + (size_t)e * 14336 * DM, p.g_pre_ffn + DM, WSC8, 0); }
            else if (l == 0 && X.c >= 128) { pg8::Gemm g{(const bf16_t*)(ws + WS_MEMN), (const bf16_t*)(ws + WS_WXKV), MEM_LEN, 2048, DM, 0, 0}; pg8::StaticOrder So; So.init(MEM_LEN, 2048, X.G, X.c - 128);
                pg8::EpiStore<0> E{KVX, 2048, 1.0f}; pg8::gemm_phase(X.lds, g, So, E, X.wv); }
            else {
            pg8::Gemm g{H, (const bf16_t*)(ws + WS_WXQ) + (size_t)l * 512 * DM, S, 512, DM, 0, 0}; pg8::StaticOrder So; So.init(S, 512, X.G, X.c);
            pg8::EpiStore<0> E{QX, 512, 1.0f}; pg8::gemm_phase(X.lds, g, So, E, X.wv); }
        }
        SEAM();
        REP(8) if (IN(8)) { PHB; phase_xattn(X, QX, KVX, OX, l); }
        SEAM();
        REP(9) if (IN(9)) { PHB;
            pg8::Gemm g{OX, (const bf16_t*)(ws + WS_WXO) + (size_t)l * DM * 512, S, DM, 512, 0, 0}; pg8::StaticOrder So; So.init(S, DM, X.G, X.c);
            pg8::EpiStore<0> E{Y, DM, 1.0f}; pg8::gemm_phase(X.lds, g, So, E, X.wv);
        }
        SEAM();
        REP(10) if (IN(10)) { PHB;
            if (NPROBE(10)) { if (l == 0) phase_norm<0, false, false, true, true>(X, p.out, XDUMMY, Y, p.g_post_x + l * DM, FFN_GU_FP8 ? nullptr : H, nullptr, nullptr, nullptr, nullptr, FFN_GU_FP8 ? ws + WS_H8 : nullptr);
                else phase_norm<0, true, false, true, true>(X, p.out, XDUMMY, Y, p.g_post_x + l * DM, H, p.w_router, p.g_pre_ffn + DM, RR, HIST); __syncthreads(); }
            if (l == 0) phase_norm<0, false, false, true, true>(X, p.out, p.out, Y, p.g_post_x + l * DM, FFN_GU_FP8 ? nullptr : H, nullptr, nullptr, nullptr, nullptr, FFN_GU_FP8 ? ws + WS_H8 : nullptr);
            else phase_norm<0, true, false, true, true>(X, p.out, p.out, Y, p.g_post_x + l * DM, H, p.w_router, p.g_pre_ffn + DM, RR, HIST);
        }
        SEAM();
        if (l == 0) {
            REP(11) if (IN(11)) { PHB;
                pg8::StaticOrder So; So.init(S, 2 * DFF, X.G, X.c);
                if (FFN_GU_FP8) { pg8::Gemm g{(const bf16_t*)(ws + WS_H8), (const bf16_t*)(ws + WS_WGU), S, 2 * DFF, DM / 2, 0, 0};
                    pg8::EpiSwiglu8 E{(unsigned char*)P, DFF, 1.0f / WSC8}; pg8::gemm_phase<pg8::EpiSwiglu8, pg8::StaticOrder, true>(X.lds, g, So, E, X.wv); }
                else { pg8::Gemm g{H, (const bf16_t*)(ws + WS_WGU), S, 2 * DFF, DM, 0, 0};
                    pg8::EpiSwiglu8 E{(unsigned char*)P, DFF, 1.0f}; pg8::gemm_phase(X.lds, g, So, E, X.wv); }
            }
            SEAM();
            REP(12) if (IN(12)) { PHB;
                pg8::Gemm g{P, (const bf16_t*)(ws + WS_WDN), S, DM, DFF / 2, 0, 0}; pg8::StaticOrder So; So.init(S, DM, X.G, X.c);
                pg8::EpiStore<0> E{Y, DM, 1.0f / WSC8}; pg8::gemm_phase<pg8::EpiStore<0>, pg8::StaticOrder, true>(X.lds, g, So, E, X.wv);
            }
            SEAM();
            REP(13) if (IN(13)) { PHB; if (NPROBE(13)) { phase_norm<0, false, false, true, true>(X, p.out, XDUMMY, Y, p.g_post_ffn + l * DM, H, nullptr, nullptr, nullptr, nullptr, ws + WS_H8); __syncthreads(); }
                phase_norm<0, false, false, true, true>(X, p.out, p.out, Y, p.g_post_ffn + l * DM, H, nullptr, nullptr, nullptr, nullptr, ws + WS_H8); }
            SEAM();
        } else {
            REP(11) if (IN(11)) { PHB; phase_assign(X, RR, HIST, TSTART, SLOTTOK, (const unsigned char*)H, (unsigned char*)Y3); }
            SEAM();
            REP(12) if (IN(12)) { PHB;
                pg8::Gemm g{Y3, (const bf16_t*)(ws + WS_WEGU), 0, 2 * DFF, DM / 2, (size_t)14336 * DM, 0}; pg8::MoeOrder<false> So; So.init(TSTART, 2 * DFF, X.G, X.c, nullptr);
                pg8::EpiSwiglu8 E{(unsigned char*)P, DFF, 1.0f / WSC8}; pg8::gemm_phase<pg8::EpiSwiglu8, pg8::MoeOrder<false>, true>(X.lds, g, So, E, X.wv);
            }
            SEAM();
            REP(13) if (IN(13)) { PHB;
                const int T = moe_tail_units(TSTART, X.G);
                { pg8::Gemm g{P, (const bf16_t*)(ws + WS_WEDN), 0, DM, DFF / 2, (size_t)DM * DFF, 0}; pg8::MoeOrder<false> So; So.init(TSTART, DM, X.G, X.c, nullptr); So.lim = So.nwg - T;
                  pg8::EpiStore<0> E{YS, DM, 1.0f / WSC8}; pg8::gemm_phase<pg8::EpiStore<0>, pg8::MoeOrder<false>, true>(X.lds, g, So, E, X.wv); }
                if (T > 0) { pg8::Gemm g{P, (const bf16_t*)(ws + WS_WEDN), 0, DM, pg8::MoeTailOrder::SLB / 2, (size_t)DM * DFF, 0, DFF / 2}; pg8::MoeTailOrder So; So.init(TSTART, DM, X.G, X.c, TSTART[8] * (DM / 256) - T, T);
                  pg8::EpiPart E{YP, 1.0f / WSC8}; pg8::gemm_phase<pg8::EpiPart, pg8::MoeTailOrder, true>(X.lds, g, So, E, X.wv); }
            }
            SEAM();
            REP(15) if (IN(15)) { PHB; phase_tailfix(X, TSTART, YP, YS); }
            SEAM();
            REP(14) if (IN(14)) { PHB; if (NPROBE(14)) { phase_norm<1, false, true, true, false>(X, p.out, XDUMMY, YS, p.g_post_ffn + l * DM, nullptr, nullptr, nullptr, RR, nullptr); __syncthreads(); }
                phase_norm<1, false, true, true, false>(X, p.out, p.out, YS, p.g_post_ffn + l * DM, nullptr, nullptr, nullptr, RR, nullptr); }
        }
}
__global__ void __launch_bounds__(512, 2) trunk_fwd(Params p_kernarg) {
    extern __shared__ __attribute__((aligned(16))) unsigned char smem_raw[];
    LAS unsigned char* const smem = (LAS unsigned char*)smem_raw;
    volatile LAS unsigned* ctl_l = (volatile LAS unsigned*)(smem + LDS_CTL_OFF);
    if (threadIdx.x < 32) ctl_l[threadIdx.x] = 0u;
    const int wv = __builtin_amdgcn_readfirstlane(threadIdx.x >> 6);
    __syncthreads();
#if ONE_LAUNCH
    (void)xcd_barrier_post((unsigned*)(p_kernarg.ws + WS_CTL), ctl_l);
    const int slot = 0;
#else
    const int slot = p_kernarg.ph_hi, lsel = p_kernarg.ph_lo;
#endif
    for (int rep_ = 0; rep_ < ((((PROBE_MASK) >> 15) & 1) ? PROBE_REPS : 1); ++rep_) if (IN0) { PHB; phase_prologue(X, p); }
#if PROBE_CVT
    { PHB; X.dry = PROBE_CVT; phase_prologue(X, p); }
#endif
    SEAM();
#if ONE_LAUNCH
    layer_body(0, slot, p_kernarg, smem, ctl_l, wv);
    layer_body(1, slot, p_kernarg, smem, ctl_l, wv);
#else
    layer_body(lsel, slot, p_kernarg, smem, ctl_l, wv);
#endif
}
#undef IN
#undef IN0
#undef SEAM
#undef PHB

extern "C" void kernel_launch(void* const* d_in, const int* in_sizes, int n_in, void* d_out, int out_size, void* d_ws, size_t ws_size, hipStream_t stream) {
    static int grid = 0;
    if (grid == 0) {
        if (n_in != 26 || out_size != S * DM || ws_size < WS_END) { fprintf(stderr, "kernel_launch: unexpected shapes (n_in %d out %d ws %zu)\n", n_in, out_size, ws_size); grid = -1; return; }
        int dev = 0, cus = 0, per_cu = 0;
        if (hipGetDevice(&dev) != hipSuccess || hipDeviceGetAttribute(&cus, hipDeviceAttributeMultiprocessorCount, dev) != hipSuccess) { grid = -1; return; }
        if (hipFuncSetAttribute((const void*)trunk_fwd, hipFuncAttributeMaxDynamicSharedMemorySize, LDS_BYTES) != hipSuccess) { fprintf(stderr, "kernel_launch: hipFuncSetAttribute failed\n"); grid = -1; return; }
        if (hipOccupancyMaxActiveBlocksPerMultiprocessor(&per_cu, (const void*)trunk_fwd, 512, LDS_BYTES) != hipSuccess || per_cu < 1) { fprintf(stderr, "kernel_launch: occupancy query says %d\n", per_cu); (void)hipGetLastError(); grid = -1; return; }
        grid = cus;
    }
    if (grid < 0) return;
    (void)hipMemsetAsync((char*)d_ws + WS_CTL, 0, CTL_ZERO_BYTES, stream);
    Params p{};
    const float** f = (const float**)&p;
    for (int i = 0; i < 26; ++i) f[i] = (const float*)d_in[i];
    p.out = (float*)d_out; p.ws = (unsigned char*)d_ws;
#if ONE_LAUNCH
    p.ph_lo = 0; p.ph_hi = 0;
    hipLaunchKernelGGL(trunk_fwd, dim3(grid), dim3(512), LDS_BYTES, stream, p);
#else
    p.ph_lo = 0; p.ph_hi = 15; hipLaunchKernelGGL(trunk_fwd, dim3(grid), dim3(512), LDS_BYTES, stream, p);
    for (int l = 0; l < DEPTH; ++l) for (int j = 0; j < 15; ++j) { if (l == 0 && j == 14) continue;
        p.ph_lo = l; p.ph_hi = j; hipLaunchKernelGGL(trunk_fwd, dim3(grid), dim3(512), LDS_BYTES, stream, p); }
#endif
}
```
